# Optimizing an MI355X kernel written in HIP

```python
import jax, jax.numpy as jnp
from jax import lax
import numpy as np

D_MODEL = 1024
BATCH = 8
SEQ = 2048
DEPTH = 2

N_MIXERS = 2
RMS_EPS = 1e-6
LN_EPS = 1e-5
CHUNK = 128
A_WIDTH = 2 * D_MODEL
A_GROUPS = 8
A_GROUP_DIM = A_WIDTH // A_GROUPS
B_WIDTH = 3 * D_MODEL // 2
B_HEADS = 12
B_HEAD_DIM = B_WIDTH // B_HEADS
CONV_WIDTH = 4
RG_C = 8.0

N_A_LAYERS = (DEPTH + 1) // 2
N_B_LAYERS = DEPTH // 2

kernel_name = "hybrid_sgu_rglru_trunk"


def rms_norm(x, w):
    xf = x.astype(jnp.float32)
    y = xf * lax.rsqrt(jnp.mean(xf * xf, axis=-1, keepdims=True) + RMS_EPS)
    return (y * w.astype(jnp.float32)).astype(x.dtype)


def layer_norm(x, w, b):
    xf = x.astype(jnp.float32)
    mu = jnp.mean(xf, axis=-1, keepdims=True)
    var = jnp.mean(jnp.square(xf - mu), axis=-1, keepdims=True)
    y = (xf - mu) * lax.rsqrt(var + LN_EPS)
    return (y * w.astype(jnp.float32) + b.astype(jnp.float32)).astype(x.dtype)


def chunked_sgu_mixer(h, w_in, ln_w, ln_b, w_s, b_s, w_out):
    B, S, _ = h.shape
    z = h @ w_in
    u, v, g = jnp.split(z, 3, axis=-1)
    u = jax.nn.gelu(u)
    v = layer_norm(jax.nn.gelu(v), ln_w, ln_b)
    v = v.reshape(B, S // CHUNK, CHUNK, A_GROUPS, A_GROUP_DIM)
    causal = jnp.tril(jnp.ones((CHUNK, CHUNK), dtype=w_s.dtype))
    w_causal = w_s * causal[None]
    s = jnp.einsum('gts,bnsgc->bntgc', w_causal, v) + b_s.T[None, None, :, :, None]
    y = u * s.reshape(B, S, A_WIDTH) * jax.nn.silu(g)
    return y @ w_out


def _linear_combine(left, right):
    a_l, b_l = left
    a_r, b_r = right
    return a_l * a_r, a_r * b_l + b_r


def rglru_mixer(h, w_in, conv_w, conv_b, gate_a_w, gate_a_b, gate_x_w, gate_x_b, lam, w_out):
    B, S, _ = h.shape
    xb, g = jnp.split(h @ w_in, 2, axis=-1)
    xp = jnp.pad(xb, ((0, 0), (CONV_WIDTH - 1, 0), (0, 0)))
    xc = conv_b + conv_w[CONV_WIDTH - 1] * xp[:, CONV_WIDTH - 1:CONV_WIDTH - 1 + S]
    for k in range(CONV_WIDTH - 1):
        xc = xc + conv_w[k] * xp[:, k:k + S]
    xh = xc.reshape(B, S, B_HEADS, B_HEAD_DIM)
    r = jax.nn.sigmoid(jnp.einsum('bshi,hij->bshj', xh, gate_a_w).reshape(B, S, B_WIDTH) + gate_a_b)
    i = jax.nn.sigmoid(jnp.einsum('bshi,hij->bshj', xh, gate_x_w).reshape(B, S, B_WIDTH) + gate_x_b)
    log_a = -RG_C * r.astype(jnp.float32) * jax.nn.softplus(-lam.astype(jnp.float32))
    a = jnp.exp(log_a)
    mult = jnp.sqrt(-jnp.expm1(2.0 * log_a))
    bterm = mult * (i * xc).astype(jnp.float32)
    _, hseq = lax.associative_scan(_linear_combine, (a, bterm), axis=1)
    y = hseq.astype(h.dtype) * jax.nn.silu(g)
    return y @ w_out


def setup_inputs(seed: int = 0) -> dict:
    key = jax.random.key(seed)
    ks = jax.random.split(key, 20)
    f32 = jnp.float32
    x = jax.random.normal(ks[0], (BATCH, SEQ, D_MODEL), f32)
    norm_w = 1.0 + 0.05 * jax.random.normal(ks[1], (DEPTH, D_MODEL), f32)
    a_w_in = jax.random.normal(ks[2], (N_A_LAYERS, D_MODEL, 3 * A_WIDTH), f32) * D_MODEL ** -0.5
    a_ln_w = 1.0 + 0.05 * jax.random.normal(ks[3], (N_A_LAYERS, A_WIDTH), f32)
    a_ln_b = 0.02 * jax.random.normal(ks[4], (N_A_LAYERS, A_WIDTH), f32)
    a_w_s = jax.random.normal(ks[5], (N_A_LAYERS, A_GROUPS, CHUNK, CHUNK), f32) * CHUNK ** -0.5
    a_b_s = 1.0 + 0.05 * jax.random.normal(ks[6], (N_A_LAYERS, A_GROUPS, CHUNK), f32)
    a_w_out = jax.random.normal(ks[7], (N_A_LAYERS, A_WIDTH, D_MODEL), f32) * A_WIDTH ** -0.5
    b_w_in = jax.random.normal(ks[8], (N_B_LAYERS, D_MODEL, 2 * B_WIDTH), f32) * D_MODEL ** -0.5
    b_conv_w = jax.random.normal(ks[9], (N_B_LAYERS, CONV_WIDTH, B_WIDTH), f32) * CONV_WIDTH ** -0.5
    b_conv_b = 0.02 * jax.random.normal(ks[10], (N_B_LAYERS, B_WIDTH), f32)
    b_gate_a_w = jax.random.normal(ks[11], (N_B_LAYERS, B_HEADS, B_HEAD_DIM, B_HEAD_DIM), f32) * B_HEAD_DIM ** -0.5
    b_gate_a_b = 0.02 * jax.random.normal(ks[12], (N_B_LAYERS, B_WIDTH), f32)
    b_gate_x_w = jax.random.normal(ks[13], (N_B_LAYERS, B_HEADS, B_HEAD_DIM, B_HEAD_DIM), f32) * B_HEAD_DIM ** -0.5
    b_gate_x_b = 0.02 * jax.random.normal(ks[14], (N_B_LAYERS, B_WIDTH), f32)
    a_c = jax.random.uniform(ks[15], (N_B_LAYERS, B_WIDTH), f32, minval=0.9, maxval=0.999)
    a0 = a_c ** (1.0 / RG_C)
    b_lambda = jnp.log(a0) - jnp.log1p(-a0)
    b_w_out = jax.random.normal(ks[16], (N_B_LAYERS, B_WIDTH, D_MODEL), f32) * B_WIDTH ** -0.5
    norm_f_w = 1.0 + 0.05 * jax.random.normal(ks[17], (D_MODEL,), f32)
    return {
        "x": x, "norm_w": norm_w,
        "a_w_in": a_w_in, "a_ln_w": a_ln_w, "a_ln_b": a_ln_b,
        "a_w_s": a_w_s, "a_b_s": a_b_s, "a_w_out": a_w_out,
        "b_w_in": b_w_in, "b_conv_w": b_conv_w, "b_conv_b": b_conv_b,
        "b_gate_a_w": b_gate_a_w, "b_gate_a_b": b_gate_a_b,
        "b_gate_x_w": b_gate_x_w, "b_gate_x_b": b_gate_x_b,
        "b_lambda": b_lambda, "b_w_out": b_w_out,
        "norm_f_w": norm_f_w,
    }


def reference(x, norm_w, a_w_in, a_ln_w, a_ln_b, a_w_s, a_b_s, a_w_out,
              b_w_in, b_conv_w, b_conv_b, b_gate_a_w, b_gate_a_b,
              b_gate_x_w, b_gate_x_b, b_lambda, b_w_out, norm_f_w):
    for layer in range(DEPTH):
        h = rms_norm(x, norm_w[layer])
        j = layer // N_MIXERS
        if layer % N_MIXERS == 0:
            y = chunked_sgu_mixer(h, a_w_in[j], a_ln_w[j], a_ln_b[j], a_w_s[j], a_b_s[j], a_w_out[j])
        else:
            y = rglru_mixer(h, b_w_in[j], b_conv_w[j], b_conv_b[j], b_gate_a_w[j], b_gate_a_b[j],
                            b_gate_x_w[j], b_gate_x_b[j], b_lambda[j], b_w_out[j])
        x = x + y
    return rms_norm(x, norm_f_w)
```

```cpp
#include <hip/hip_runtime.h>
#include <math.h>

namespace {
constexpr int D = 1024, NB = 8, S = 2048, M = NB * S;
constexpr int AW = 2048, AG = 8, AGD = 256, CH = 128;
constexpr int BW = 1536, BH = 12, BD = 128;

__device__ __forceinline__ float gelu_tanh(float x) { const float x3 = x * x * x; return 0.5f * x * (1.f + tanhf(0.7978845608028654f * (x + 0.044715f * x3))); }
__device__ __forceinline__ float sigm(float x) { return 1.f / (1.f + expf(-x)); }
__device__ __forceinline__ float silu(float x) { return x * sigm(x); }

__global__ __launch_bounds__(256) void k_rowrstd(const float* __restrict__ x, float* __restrict__ rs, int rows) {
    const int w = (blockIdx.x * 256 + threadIdx.x) >> 6, lane = threadIdx.x & 63;
    if (w >= rows) return;
    const float4* xr = (const float4*)(x + (size_t)w * D);
    float s = 0.f;
    for (int j = 0; j < 4; ++j) { const float4 v = xr[lane + 64 * j]; s += v.x * v.x + v.y * v.y + v.z * v.z + v.w * v.w; }
    for (int o = 32; o >= 1; o >>= 1) s += __shfl_xor(s, o);
    if (lane == 0) rs[w] = rsqrtf(s * (1.f / D) + 1e-6f);
}
__global__ __launch_bounds__(256) void k_rmsnorm_inplace(float* __restrict__ x, const float* __restrict__ w, int rows) {
    const int r = (blockIdx.x * 256 + threadIdx.x) >> 6, lane = threadIdx.x & 63;
    if (r >= rows) return;
    float4* xr = (float4*)(x + (size_t)r * D);
    float4 v[4]; float s = 0.f;
    for (int j = 0; j < 4; ++j) { v[j] = xr[lane + 64 * j]; s += v[j].x * v[j].x + v[j].y * v[j].y + v[j].z * v[j].z + v[j].w * v[j].w; }
    for (int o = 32; o >= 1; o >>= 1) s += __shfl_xor(s, o);
    const float rstd = rsqrtf(s * (1.f / D) + 1e-6f);
    for (int j = 0; j < 4; ++j) { const float4 ww = ((const float4*)w)[lane + 64 * j]; float4 o;
        o.x = v[j].x * rstd * ww.x; o.y = v[j].y * rstd * ww.y; o.z = v[j].z * rstd * ww.z; o.w = v[j].w * rstd * ww.w; xr[lane + 64 * j] = o; }
}

enum { EPI_PLAIN = 0, EPI_GELU = 1, EPI_MULSILU = 2, EPI_ADDR = 3 };
template <int EPI>
__global__ __launch_bounds__(256) void k_gemm(const float* __restrict__ A, int lda, const float* __restrict__ rs, const float* __restrict__ ks,
                                              const float* __restrict__ Bm, int ldb, float* C, int ldc, const float* R, int ldr, int Kk) {
    __shared__ float As[16][132];
    __shared__ float Bs[16][132];
    const int tid = threadIdx.x, tx = tid & 15, ty = tid >> 4;
    const int bm = blockIdx.y * 128, bn = blockIdx.x * 128;
    float acc[8][8];
#pragma unroll
    for (int i = 0; i < 8; ++i)
#pragma unroll
        for (int j = 0; j < 8; ++j) acc[i][j] = 0.f;
    for (int k0 = 0; k0 < Kk; k0 += 16) {
#pragma unroll
        for (int i = 0; i < 2; ++i) {
            const int idx = tid + i * 256, r = idx >> 2, c4 = (idx & 3) * 4;
            float4 v = *(const float4*)(A + (size_t)(bm + r) * lda + k0 + c4);
            if (rs) { const float s = rs[bm + r]; v.x *= s; v.y *= s; v.z *= s; v.w *= s; }
            if (ks) { const float4 q = *(const float4*)(ks + k0 + c4); v.x *= q.x; v.y *= q.y; v.z *= q.z; v.w *= q.w; }
            As[c4 + 0][r] = v.x; As[c4 + 1][r] = v.y; As[c4 + 2][r] = v.z; As[c4 + 3][r] = v.w;
        }
#pragma unroll
        for (int i = 0; i < 2; ++i) {
            const int idx = tid + i * 256, r = idx >> 5, c4 = (idx & 31) * 4;
            *(float4*)&Bs[r][c4] = *(const float4*)(Bm + (size_t)(k0 + r) * ldb + bn + c4);
        }
        __syncthreads();
#pragma unroll
        for (int kk = 0; kk < 16; ++kk) {
            const float4 a0 = *(const float4*)&As[kk][ty * 4], a1 = *(const float4*)&As[kk][64 + ty * 4];
            const float4 b0 = *(const float4*)&Bs[kk][tx * 4], b1 = *(const float4*)&Bs[kk][64 + tx * 4];
            const float a[8] = {a0.x, a0.y, a0.z, a0.w, a1.x, a1.y, a1.z, a1.w};
            const float b[8] = {b0.x, b0.y, b0.z, b0.w, b1.x, b1.y, b1.z, b1.w};
#pragma unroll
            for (int i = 0; i < 8; ++i)
#pragma unroll
                for (int j = 0; j < 8; ++j) acc[i][j] = fmaf(a[i], b[j], acc[i][j]);
        }
        __syncthreads();
    }
#pragma unroll
    for (int i = 0; i < 8; ++i) {
        const int m = bm + (i < 4 ? ty * 4 + i : 64 + ty * 4 + (i - 4));
#pragma unroll
        for (int jh = 0; jh < 2; ++jh) {
            const int n = bn + jh * 64 + tx * 4;
            float4 o = {acc[i][jh * 4 + 0], acc[i][jh * 4 + 1], acc[i][jh * 4 + 2], acc[i][jh * 4 + 3]};
            float4* cp = (float4*)(C + (size_t)m * ldc + n);
            if (EPI == EPI_GELU) { o.x = gelu_tanh(o.x); o.y = gelu_tanh(o.y); o.z = gelu_tanh(o.z); o.w = gelu_tanh(o.w); }
            if (EPI == EPI_MULSILU) { const float4 c = *cp; o.x = c.x * silu(o.x); o.y = c.y * silu(o.y); o.z = c.z * silu(o.z); o.w = c.w * silu(o.w); }
            if (EPI == EPI_ADDR) { const float4 r = *(const float4*)(R + (size_t)m * ldr + n); o.x += r.x; o.y += r.y; o.z += r.z; o.w += r.w; }
            *cp = o;
        }
    }
}

__global__ __launch_bounds__(256) void k_ln_inplace(float* __restrict__ v, const float* __restrict__ w, const float* __restrict__ b) {
    __shared__ float red[8];
    float4* vr = (float4*)(v + (size_t)blockIdx.x * AW);
    const int tid = threadIdx.x, lane = tid & 63, wv = tid >> 6;
    float4 a0 = vr[tid], a1 = vr[tid + 256];
    float s = a0.x + a0.y + a0.z + a0.w + a1.x + a1.y + a1.z + a1.w;
    for (int o = 32; o >= 1; o >>= 1) s += __shfl_xor(s, o);
    if (lane == 0) red[wv] = s;
    __syncthreads();
    const float mean = (red[0] + red[1] + red[2] + red[3]) * (1.f / AW);
    a0.x -= mean; a0.y -= mean; a0.z -= mean; a0.w -= mean; a1.x -= mean; a1.y -= mean; a1.z -= mean; a1.w -= mean;
    float q = a0.x * a0.x + a0.y * a0.y + a0.z * a0.z + a0.w * a0.w + a1.x * a1.x + a1.y * a1.y + a1.z * a1.z + a1.w * a1.w;
    for (int o = 32; o >= 1; o >>= 1) q += __shfl_xor(q, o);
    if (lane == 0) red[4 + wv] = q;
    __syncthreads();
    const float rstd = rsqrtf((red[4] + red[5] + red[6] + red[7]) * (1.f / AW) + 1e-5f);
    const float4 w0 = ((const float4*)w)[tid], w1 = ((const float4*)w)[tid + 256], b0 = ((const float4*)b)[tid], b1 = ((const float4*)b)[tid + 256];
    a0.x = a0.x * rstd * w0.x + b0.x; a0.y = a0.y * rstd * w0.y + b0.y; a0.z = a0.z * rstd * w0.z + b0.z; a0.w = a0.w * rstd * w0.w + b0.w;
    a1.x = a1.x * rstd * w1.x + b1.x; a1.y = a1.y * rstd * w1.y + b1.y; a1.z = a1.z * rstd * w1.z + b1.z; a1.w = a1.w * rstd * w1.w + b1.w;
    vr[tid] = a0; vr[tid + 256] = a1;
}

__global__ __launch_bounds__(256) void k_sgu(float* __restrict__ p, const float* __restrict__ vn, const float* __restrict__ ws, const float* __restrict__ bs) {
    const int g = blockIdx.x % AG, rt = blockIdx.x / AG, t = rt % CH, chunk = rt / CH;
    const int col = g * AGD + threadIdx.x;
    const float* wr = ws + ((size_t)g * CH + t) * CH;
    const float* vb = vn + (size_t)chunk * CH * AW + col;
    float acc = 0.f;
    for (int s = 0; s <= t; ++s) acc = fmaf(wr[s], vb[(size_t)s * AW], acc);
    acc += bs[g * CH + t];
    p[(size_t)rt * AW + col] *= acc;
}

__global__ __launch_bounds__(256) void k_conv(const float* __restrict__ xb, const float* __restrict__ cw, const float* __restrict__ cb, float* __restrict__ xc, int rows) {
    const size_t i = (size_t)blockIdx.x * 256 + threadIdx.x;
    if (i >= (size_t)rows * BW) return;
    const int c = (int)(i % BW), r = (int)(i / BW), t = r % S;
    float acc = cb[c];
#pragma unroll
    for (int k = 0; k < 4; ++k) { const int tt = t - 3 + k; if (tt >= 0) acc = fmaf(cw[k * BW + c], xb[(size_t)(r - 3 + k) * BW + c], acc); }
    xc[i] = acc;
}

__global__ __launch_bounds__(128) void k_gates(const float* __restrict__ xc, const float* __restrict__ Wa, const float* __restrict__ ba, const float* __restrict__ Wx, const float* __restrict__ bx,
                                               const float* __restrict__ lam, float* __restrict__ aout, float* __restrict__ bout) {
    __shared__ float xs[BD];
    const int h = blockIdx.x % BH, r = blockIdx.x / BH, j = threadIdx.x;
    const float* xr = xc + (size_t)r * BW + h * BD;
    xs[j] = xr[j];
    __syncthreads();
    const float* wa = Wa + (size_t)h * BD * BD + j; const float* wx = Wx + (size_t)h * BD * BD + j;
    float ra = 0.f, rx = 0.f;
    for (int i = 0; i < BD; ++i) { ra = fmaf(xs[i], wa[(size_t)i * BD], ra); rx = fmaf(xs[i], wx[(size_t)i * BD], rx); }
    const int c = h * BD + j;
    const float rg = sigm(ra + ba[c]), ig = sigm(rx + bx[c]);
    const float nl = -lam[c];
    const float sp = fmaxf(nl, 0.f) + log1pf(expf(-fabsf(nl)));
    const float log_a = -8.0f * rg * sp;
    const float a = expf(log_a);
    const float mult = sqrtf(-expm1f(2.0f * log_a));
    aout[(size_t)r * BW + c] = a;
    bout[(size_t)r * BW + c] = mult * (ig * xs[j]);
}

__global__ __launch_bounds__(64) void k_scan(const float* __restrict__ a, const float* __restrict__ b, float* __restrict__ g, int nbatch) {
    const int i = blockIdx.x * 64 + threadIdx.x;
    if (i >= nbatch * BW) return;
    const int c = i % BW, bb = i / BW;
    const size_t base = (size_t)bb * S * BW + c;
    float h = 0.f;
    for (int t0 = 0; t0 < S; t0 += 8) {
        float av[8], bv[8], gv[8];
#pragma unroll
        for (int k = 0; k < 8; ++k) { const size_t o = base + (size_t)(t0 + k) * BW; av[k] = a[o]; bv[k] = b[o]; gv[k] = g[o]; }
#pragma unroll
        for (int k = 0; k < 8; ++k) { h = fmaf(av[k], h, bv[k]); g[base + (size_t)(t0 + k) * BW] = h * silu(gv[k]); }
    }
}
}

extern "C" void kernel_launch(void* const* d_in, const int* in_sizes, int n_in, void* d_out, int out_size, void* d_ws, size_t ws_size, hipStream_t stream) {
    const float* x = (const float*)d_in[0];
    const float* norm_w = (const float*)d_in[1];
    const float* a_w_in = (const float*)d_in[2];
    const float* a_ln_w = (const float*)d_in[3];
    const float* a_ln_b = (const float*)d_in[4];
    const float* a_w_s = (const float*)d_in[5];
    const float* a_b_s = (const float*)d_in[6];
    const float* a_w_out = (const float*)d_in[7];
    const float* b_w_in = (const float*)d_in[8];
    const float* b_conv_w = (const float*)d_in[9];
    const float* b_conv_b = (const float*)d_in[10];
    const float* b_gate_a_w = (const float*)d_in[11];
    const float* b_gate_a_b = (const float*)d_in[12];
    const float* b_gate_x_w = (const float*)d_in[13];
    const float* b_gate_x_b = (const float*)d_in[14];
    const float* b_lambda = (const float*)d_in[15];
    const float* b_w_out = (const float*)d_in[16];
    const float* norm_f_w = (const float*)d_in[17];
    float* out = (float*)d_out;
    float* ws = (float*)d_ws;
    constexpr int MH = M / 2;
    constexpr size_t MiBf = (1u << 20) / 4;
    float* P = ws;
    float* V = ws + 64 * MiBf;
    float* XB = ws;
    float* GG = ws + 48 * MiBf;
    float* XC = ws + 96 * MiBf;
    float* AA = ws + 144 * MiBf;
    float* RS = ws + 200 * MiBf;
    for (int half = 0; half < 2; ++half) {
        const float* xh = x + (size_t)half * MH * D;
        float* oh = out + (size_t)half * MH * D;
        k_rowrstd<<<MH / 4, 256, 0, stream>>>(xh, RS, MH);
        k_gemm<EPI_GELU><<<dim3(AW / 128, MH / 128), 256, 0, stream>>>(xh, D, RS, norm_w, a_w_in, 3 * AW, P, AW, nullptr, 0, D);
        k_gemm<EPI_MULSILU><<<dim3(AW / 128, MH / 128), 256, 0, stream>>>(xh, D, RS, norm_w, a_w_in + 2 * AW, 3 * AW, P, AW, nullptr, 0, D);
        k_gemm<EPI_GELU><<<dim3(AW / 128, MH / 128), 256, 0, stream>>>(xh, D, RS, norm_w, a_w_in + AW, 3 * AW, V, AW, nullptr, 0, D);
        k_ln_inplace<<<MH, 256, 0, stream>>>(V, a_ln_w, a_ln_b);
        k_sgu<<<MH * AG, 256, 0, stream>>>(P, V, a_w_s, a_b_s);
        k_gemm<EPI_ADDR><<<dim3(D / 128, MH / 128), 256, 0, stream>>>(P, AW, nullptr, nullptr, a_w_out, D, oh, D, xh, D, AW);
        k_rowrstd<<<MH / 4, 256, 0, stream>>>(oh, RS, MH);
        k_gemm<EPI_PLAIN><<<dim3(BW / 128, MH / 128), 256, 0, stream>>>(oh, D, RS, norm_w + D, b_w_in, 2 * BW, XB, BW, nullptr, 0, D);
        k_gemm<EPI_PLAIN><<<dim3(BW / 128, MH / 128), 256, 0, stream>>>(oh, D, RS, norm_w + D, b_w_in + BW, 2 * BW, GG, BW, nullptr, 0, D);
        k_conv<<<(unsigned)(((size_t)MH * BW + 255) / 256), 256, 0, stream>>>(XB, b_conv_w, b_conv_b, XC, MH);
        k_gates<<<MH * BH, 128, 0, stream>>>(XC, b_gate_a_w, b_gate_a_b, b_gate_x_w, b_gate_x_b, b_lambda, AA, XB);
        k_scan<<<(MH / S) * BW / 64, 64, 0, stream>>>(AA, XB, GG, MH / S);
        k_gemm<EPI_ADDR><<<dim3(D / 128, MH / 128), 256, 0, stream>>>(GG, BW, nullptr, nullptr, b_w_out, D, oh, D, oh, D, BW);
        k_rmsnorm_inplace<<<MH / 4, 256, 0, stream>>>(oh, norm_f_w, MH);
    }
}
```

```cpp
#include <hip/hip_runtime.h>
#include <cstdio>
#include <cstdint>
namespace pg8 {
#define PG8_LAS __attribute__((address_space(3)))
typedef unsigned short bf16_t;
typedef short bf16x8 __attribute__((ext_vector_type(8)));
typedef float f32x4 __attribute__((ext_vector_type(4)));
typedef unsigned u32x4 __attribute__((ext_vector_type(4)));
constexpr int BM = 256, BK = 64, HALF = 128, HTB = HALF * BK * 2  , STAGE_BYTES = 8 * HTB, NXCD = 8, WGM = 8;

__host__ __device__ __forceinline__ int lds_byte(int r, int c) { const int st = (r >> 4) * 2 + (c >> 5), rr = r & 15, cc = c & 31, ob = rr * 64 + cc * 2; return st * 1024 + (ob ^ (((ob >> 9) & 1) << 5)); }
__host__ __device__ __forceinline__ void stage_rc(int b, int& R, int& C) { const int st = b / 1024, sb = b % 1024, swz = sb ^ (((sb >> 9) & 1) << 5); R = (st >> 1) * 16 + swz / 64; C = (st & 1) * 32 + (swz % 64) / 2; }
__host__ __device__ __forceinline__ int perm32(int rho) { const int n = rho >> 4, i = rho & 15; return 8 * (i >> 2) + 4 * n + (i & 3); }

struct Unit { int pm, pn; };
struct Gemm { const bf16_t* A; const bf16_t* Bt; int M, N, K; };

struct StaticOrder {
    int nM, nN, nwg, G, c;
    __host__ __device__ void init(int M, int N, int G_, int c_) { nM = M / BM; nN = N / BM; nwg = nM * nN; G = G_; c = c_; }
    __host__ __device__ bool next(int i, Unit& u) const {
        const long L = (long)i * G + c; if (L >= nwg) return false;
        int wgid = (int)L; { const int q = nwg / NXCD, r = nwg % NXCD, xcd = wgid % NXCD, off = wgid / NXCD; wgid = (xcd < r ? xcd * (q + 1) : r * (q + 1) + (xcd - r) * q) + off; }
        const int nig = WGM * nN, gid = wgid / nig, fm = gid * WGM, gsz = (nM - fm) < WGM ? (nM - fm) : WGM;
        u.pm = fm + ((wgid % nig) % gsz); u.pn = (wgid % nig) / gsz; return true;
    }
    __device__ __forceinline__ void a_ready(const Unit&) const {}
    __device__ __forceinline__ void done(const Unit&) const {}
};

__device__ __forceinline__ unsigned cvt_pk_bf16(float lo, float hi) { unsigned r; asm volatile("v_cvt_pk_bf16_f32 %0, %1, %2" : "=v"(r) : "v"(lo), "v"(hi)); return r; }
typedef float f32x2 __attribute__((ext_vector_type(2)));
typedef unsigned u32x2 __attribute__((ext_vector_type(2)));
__device__ __forceinline__ float bf_lo(unsigned w) { return __uint_as_float(w << 16); }
__device__ __forceinline__ float bf_hi(unsigned w) { return __uint_as_float(w & 0xffff0000u); }
__device__ __forceinline__ float act_ug(float u, float g) {
    const float t = u * (u * u * (0.044715f * -2.302208198f) + -2.302208198f);
    const float e1 = __builtin_amdgcn_exp2f(t), e2 = __builtin_amdgcn_exp2f(g * -1.442695041f);
    return (u * g) * __builtin_amdgcn_rcpf((1.0f + e1) * (1.0f + e2));
}
__device__ __forceinline__ float act_gelu(float u) {
    const float t = u * (u * u * (0.044715f * -2.302208198f) + -2.302208198f);
    return u * __builtin_amdgcn_rcpf(1.0f + __builtin_amdgcn_exp2f(t));
}
__device__ __forceinline__ float act_silu(float g) { return g * __builtin_amdgcn_rcpf(1.0f + __builtin_amdgcn_exp2f(g * -1.442695041f)); }

struct EpiUG {
    static constexpr bool PERM = true, AFTER_DRAIN = false;
    bf16_t* P; const float* rs;
    __device__ __forceinline__ void operator()(const f32x4 (&acc)[2][2][4][2], const Unit& u, int wr, int wc, int fr, int fq) const {
        const int row0 = u.pm * BM + wr * 64 + fr, col0 = u.pn * 128 + wc * 32 + 8 * fq;
#pragma unroll
        for (int ai = 0; ai < 2; ++ai)
#pragma unroll
            for (int m = 0; m < 4; ++m) {
                const int r = row0 + ai * HALF + m * 16; const float s = rs[r];
                const f32x4 u0 = acc[ai][0][m][0] * s, u1 = acc[ai][0][m][1] * s, g0 = acc[ai][1][m][0] * s, g1 = acc[ai][1][m][1] * s;
                u32x4 w;
                w.x = cvt_pk_bf16(act_ug(u0[0], g0[0]), act_ug(u0[1], g0[1])); w.y = cvt_pk_bf16(act_ug(u0[2], g0[2]), act_ug(u0[3], g0[3]));
                w.z = cvt_pk_bf16(act_ug(u1[0], g1[0]), act_ug(u1[1], g1[1])); w.w = cvt_pk_bf16(act_ug(u1[2], g1[2]), act_ug(u1[3], g1[3]));
                *(u32x4*)(P + (size_t)r * 2048 + col0) = w;
            }
    }
};
struct EpiVT {
    static constexpr bool PERM = true, AFTER_DRAIN = false;
    bf16_t* VT; const float* rs; float* ST; int ntok;
    __device__ __forceinline__ void operator()(const f32x4 (&acc)[2][2][4][2], const Unit& u, int wr, int wc, int fr, int fq) const {
        const int vrow0 = u.pm * BM + wr * 64 + fr, tok0 = u.pn * BM + wc * 32 + 8 * fq;
        f32x4 rsv[2][2];
#pragma unroll
        for (int bj = 0; bj < 2; ++bj)
#pragma unroll
            for (int n = 0; n < 2; ++n) rsv[bj][n] = *(const f32x4*)(rs + tok0 + bj * HALF + 4 * n);
        float S[16], Q[16];
#pragma unroll
        for (int i = 0; i < 16; ++i) { S[i] = 0.f; Q[i] = 0.f; }
#pragma unroll
        for (int ai = 0; ai < 2; ++ai)
#pragma unroll
            for (int m = 0; m < 4; ++m) {
                bf16_t* rowp = VT + (size_t)(vrow0 + ai * HALF + m * 16) * ntok + tok0;
#pragma unroll
                for (int bj = 0; bj < 2; ++bj) {
                    float v[8];
#pragma unroll
                    for (int n = 0; n < 2; ++n)
#pragma unroll
                        for (int e = 0; e < 4; ++e) { const float x = act_gelu(acc[ai][bj][m][n][e] * rsv[bj][n][e]); v[n * 4 + e] = x; S[bj * 8 + n * 4 + e] += x; Q[bj * 8 + n * 4 + e] += x * x; }
                    u32x4 w; w.x = cvt_pk_bf16(v[0], v[1]); w.y = cvt_pk_bf16(v[2], v[3]); w.z = cvt_pk_bf16(v[4], v[5]); w.w = cvt_pk_bf16(v[6], v[7]);
                    *(u32x4*)(rowp + bj * HALF) = w;
                }
            }
#pragma unroll
        for (int k = 0; k < 4; ++k) {
            const bool hi = (fr >> k) & 1;
#pragma unroll
            for (int i = 0; i < (8 >> k); ++i) {
                const float s_lo = S[2 * i], s_hi = S[2 * i + 1], q_lo = Q[2 * i], q_hi = Q[2 * i + 1];
                const float s_send = hi ? s_lo : s_hi, q_send = hi ? q_lo : q_hi;
                const float s_keep = hi ? s_hi : s_lo, q_keep = hi ? q_hi : q_lo;
                S[i] = s_keep + __shfl_xor(s_send, 1 << k); Q[i] = q_keep + __shfl_xor(q_send, 1 << k);
            }
        }
        const int tok = u.pn * BM + (fr >> 3) * HALF + wc * 32 + 8 * fq + (fr & 7);
        *(f32x2*)(ST + ((size_t)(2 * u.pm + wr) * ntok + tok) * 2) = (f32x2){S[0], Q[0]};
    }
};
struct EpiRes1 {
    static constexpr bool PERM = true, AFTER_DRAIN = false;
    const float* X; float* X1; bf16_t* X1B; float* SS;
    __device__ __forceinline__ void operator()(const f32x4 (&acc)[2][2][4][2], const Unit& u, int wr, int wc, int fr, int fq) const {
        const int row0 = u.pm * BM + wr * 64 + fr, col0 = u.pn * BM + wc * 32 + 8 * fq;
#pragma unroll
        for (int ai = 0; ai < 2; ++ai)
#pragma unroll
            for (int m = 0; m < 4; ++m) {
                const int r = row0 + ai * HALF + m * 16; const size_t off = (size_t)r * 1024 + col0; float ss = 0.f;
#pragma unroll
                for (int bj = 0; bj < 2; ++bj) {
                    const f32x4 a0 = *(const f32x4*)(X + off + bj * HALF) + acc[ai][bj][m][0], a1 = *(const f32x4*)(X + off + bj * HALF + 4) + acc[ai][bj][m][1];
                    *(f32x4*)(X1 + off + bj * HALF) = a0; *(f32x4*)(X1 + off + bj * HALF + 4) = a1;
                    u32x4 w; w.x = cvt_pk_bf16(a0[0], a0[1]); w.y = cvt_pk_bf16(a0[2], a0[3]); w.z = cvt_pk_bf16(a1[0], a1[1]); w.w = cvt_pk_bf16(a1[2], a1[3]);
                    *(u32x4*)(X1B + off + bj * HALF) = w;
                    ss += (a0[0] * a0[0] + a0[1] * a0[1]) + (a0[2] * a0[2] + a0[3] * a0[3]) + (a1[0] * a1[0] + a1[1] * a1[1]) + (a1[2] * a1[2] + a1[3] * a1[3]);
                }
                ss += __shfl_xor(ss, 16); ss += __shfl_xor(ss, 32);
                if (fq == 0) SS[(size_t)r * 16 + 4 * u.pn + wc] = ss;
            }
    }
};
struct EpiXG {
    static constexpr bool PERM = true, AFTER_DRAIN = false;
    bf16_t* XB; bf16_t* SG; const float* SS;
    __device__ __forceinline__ void operator()(const f32x4 (&acc)[2][2][4][2], const Unit& u, int wr, int wc, int fr, int fq) const {
        const int row0 = u.pm * BM + wr * 64 + fr; const bool isg = u.pn >= 6;
        const int col0 = (isg ? u.pn - 6 : u.pn) * BM + wc * 32 + 8 * fq; bf16_t* O = isg ? SG : XB;
#pragma unroll
        for (int ai = 0; ai < 2; ++ai)
#pragma unroll
            for (int m = 0; m < 4; ++m) {
                const int r = row0 + ai * HALF + m * 16;
                const f32x4 pp = *(const f32x4*)(SS + (size_t)r * 16 + 4 * fq); float ss = (pp[0] + pp[1]) + (pp[2] + pp[3]);
                ss += __shfl_xor(ss, 16); ss += __shfl_xor(ss, 32);
                const float s = __builtin_amdgcn_rsqf(ss * (1.0f / 1024.0f) + 1e-6f);
#pragma unroll
                for (int bj = 0; bj < 2; ++bj) {
                    f32x4 v0 = acc[ai][bj][m][0] * s, v1 = acc[ai][bj][m][1] * s;
                    if (isg) {
#pragma unroll
                        for (int e = 0; e < 4; ++e) { v0[e] = act_silu(v0[e]); v1[e] = act_silu(v1[e]); } }
                    u32x4 w; w.x = cvt_pk_bf16(v0[0], v0[1]); w.y = cvt_pk_bf16(v0[2], v0[3]); w.z = cvt_pk_bf16(v1[0], v1[1]); w.w = cvt_pk_bf16(v1[2], v1[3]);
                    *(u32x4*)(O + (size_t)r * 1536 + col0 + bj * HALF) = w;
                }
            }
    }
};
struct EpiRes2 {
    static constexpr bool PERM = true, AFTER_DRAIN = false;
    float* X1;
    __device__ __forceinline__ void operator()(const f32x4 (&acc)[2][2][4][2], const Unit& u, int wr, int wc, int fr, int fq) const {
        const int row0 = u.pm * BM + wr * 64 + fr, col0 = u.pn * BM + wc * 32 + 8 * fq;
#pragma unroll
        for (int ai = 0; ai < 2; ++ai)
#pragma unroll
            for (int m = 0; m < 4; ++m) {
                const size_t off = (size_t)(row0 + ai * HALF + m * 16) * 1024 + col0;
#pragma unroll
                for (int bj = 0; bj < 2; ++bj) {
                    const f32x4 a0 = *(const f32x4*)(X1 + off + bj * HALF) + acc[ai][bj][m][0], a1 = *(const f32x4*)(X1 + off + bj * HALF + 4) + acc[ai][bj][m][1];
                    *(f32x4*)(X1 + off + bj * HALF) = a0; *(f32x4*)(X1 + off + bj * HALF + 4) = a1;
                }
            }
    }
};
template <class Epi, class Sched, bool ALIGN_EPI = false, bool SP2 = false>
__device__ __forceinline__ void gemm_phase(PG8_LAS unsigned char* lds, const Gemm g, const Sched& S, const Epi& E) {
    const int tid = threadIdx.x, wid = __builtin_amdgcn_readfirstlane(tid >> 6), lane = tid & 63, wr = wid >> 2, wc = wid & 3, fr = lane & 15, fq = lane >> 4;
    const int K = g.K, nt = K / BK;
    unsigned voffA[2], voffB[2];
#pragma unroll
    for (int i = 0; i < 2; ++i) { int R, C; stage_rc(tid * 16 + i * 8192, R, C); const int Rb = Epi::PERM ? ((R & ~31) + perm32(R & 31)) : R;
        voffA[i] = (unsigned)(R * K + C) * 2u; voffB[i] = (unsigned)(Rb * K + C) * 2u; }
    const size_t kstep = (size_t)(BK * 2);
    const size_t hstep = (size_t)HALF * K * 2;
    const size_t tstep = 2 * hstep;
    const unsigned ldsw = (unsigned)wid * 1024u;
    const int aoff = lds_byte(wr * 64 + fr, fq * 8), boff = lds_byte(wc * 32 + fr, fq * 8);
#define PG8_SA(b, h) (((b) * 2 + (h)) * HTB)
#define PG8_SB(b, h) ((4 + (b) * 2 + (h)) * HTB)
#define PG8_STAGE(bufoff, gbase, voff) do { _Pragma("unroll") for (int _i = 0; _i < 2; ++_i) \
        __builtin_amdgcn_global_load_lds((const unsigned*)((const char*)(gbase) + (voff)[_i]), (PG8_LAS unsigned*)(lds + (bufoff) + ldsw + _i * 8192), 16, 0, 0); } while (0)
#define PG8_LDA(dst, b, h) do { _Pragma("unroll") for (int m = 0; m < 4; ++m) _Pragma("unroll") for (int k = 0; k < 2; ++k) dst[m][k] = *(const PG8_LAS bf16x8*)(lds + PG8_SA(b, h) + aoff + m * 2048 + k * 1024); } while (0)
#define PG8_LDB(dst, b, h) do { _Pragma("unroll") for (int n = 0; n < 2; ++n) _Pragma("unroll") for (int k = 0; k < 2; ++k) dst[n][k] = *(const PG8_LAS bf16x8*)(lds + PG8_SB(b, h) + boff + n * 2048 + k * 1024); } while (0)
#define PG8_MMA(ai, bj, At, Bt) do { __builtin_amdgcn_s_setprio(1); _Pragma("unroll") for (int m = 0; m < 4; ++m) _Pragma("unroll") for (int n = 0; n < 2; ++n) _Pragma("unroll") for (int k = 0; k < 2; ++k) \
        acc[ai][bj][m][n] = __builtin_amdgcn_mfma_f32_16x16x32_bf16(Bt[n][k], At[m][k], acc[ai][bj][m][n], 0, 0, 0); __builtin_amdgcn_s_setprio(0); } while (0)
#define PG8_WAIT_V(n) asm volatile("s_waitcnt vmcnt(" #n ")" ::: "memory")
#define PG8_WAIT_L(n) asm volatile("s_waitcnt lgkmcnt(" #n ")" ::: "memory")
#define PG8_BAR __builtin_amdgcn_s_barrier()
#define PG8_SCHED __builtin_amdgcn_sched_barrier(0)
    Unit cur, nxt; int ui = 0;
    if (!S.next(0, cur)) return;
    f32x4 acc[2][2][4][2];
#pragma unroll
    for (int a = 0; a < 2; ++a)
#pragma unroll
        for (int b = 0; b < 2; ++b)
#pragma unroll
            for (int m = 0; m < 4; ++m)
#pragma unroll
                for (int n = 0; n < 2; ++n) acc[a][b][m][n] = (f32x4){0.f, 0.f, 0.f, 0.f};
    bf16x8 At[4][2], B0[2][2], B1[2][2];
    const char* cA = (const char*)g.A + (size_t)cur.pm * tstep; const char* cB = (const char*)g.Bt + (size_t)cur.pn * tstep;
    S.a_ready(cur);
    if constexpr (SP2) {
        PG8_STAGE(PG8_SB(0, 0), cB, voffB); PG8_STAGE(PG8_SB(0, 1), cB + hstep, voffB); PG8_STAGE(PG8_SA(0, 0), cA, voffA); PG8_STAGE(PG8_SA(0, 1), cA + hstep, voffA);
        if (wr == 1) PG8_BAR;
        PG8_WAIT_V(2); PG8_BAR;
        PG8_STAGE(PG8_SB(1, 0), cB + kstep, voffB); PG8_STAGE(PG8_SA(1, 0), cA + kstep, voffA); PG8_STAGE(PG8_SB(1, 1), cB + hstep + kstep, voffB);
        PG8_WAIT_V(6); PG8_BAR;
    } else {
        PG8_STAGE(PG8_SB(0, 0), cB, voffB); PG8_STAGE(PG8_SA(0, 0), cA, voffA); PG8_STAGE(PG8_SB(0, 1), cB + hstep, voffB); PG8_STAGE(PG8_SA(0, 1), cA + hstep, voffA);
        if (wr == 1) PG8_BAR;
        PG8_WAIT_V(4); PG8_BAR;
        PG8_STAGE(PG8_SB(1, 0), cB + kstep, voffB); PG8_STAGE(PG8_SA(1, 0), cA + kstep, voffA); PG8_STAGE(PG8_SB(1, 1), cB + hstep + kstep, voffB);
        PG8_WAIT_V(6); PG8_BAR;
    }
    for (;;) {
        const bool has_next = S.next(ui + 1, nxt);
        const char* nA = has_next ? (const char*)g.A + (size_t)nxt.pm * tstep : cA; const char* nB = has_next ? (const char*)g.Bt + (size_t)nxt.pn * tstep : cB;
        for (int t = 0; t < nt; t += 2) {
            const bool last = (t == nt - 2);
            const char* a1 = cA + (size_t)(t + 1) * kstep;
            const char* a2 = last ? nA : cA + (size_t)(t + 2) * kstep; const char* b2 = last ? nB : cB + (size_t)(t + 2) * kstep;
            const char* a3 = a2 + kstep; const char* b3 = b2 + kstep;
            if (last && has_next) S.a_ready(nxt);
            if constexpr (SP2) {
            PG8_LDB(B0, 0, 0); PG8_LDB(B1, 0, 1); PG8_SCHED; PG8_LDA(At, 0, 0); PG8_STAGE(PG8_SA(1, 1), a1 + hstep, voffA);
            PG8_WAIT_V(8); PG8_WAIT_L(0); PG8_BAR; PG8_MMA(0, 0, At, B0); PG8_MMA(0, 1, At, B1); PG8_BAR; PG8_SCHED;
            PG8_LDA(At, 0, 1); PG8_STAGE(PG8_SB(0, 0), b2, voffB); PG8_STAGE(PG8_SB(0, 1), b2 + hstep, voffB); PG8_STAGE(PG8_SA(0, 0), a2, voffA);
            PG8_WAIT_V(8); PG8_WAIT_L(0); PG8_BAR; PG8_MMA(1, 0, At, B0); PG8_MMA(1, 1, At, B1); PG8_BAR; PG8_SCHED;
            PG8_LDB(B0, 1, 0); PG8_LDB(B1, 1, 1); PG8_SCHED; PG8_LDA(At, 1, 0); PG8_STAGE(PG8_SA(0, 1), a2 + hstep, voffA);
            PG8_WAIT_V(8); PG8_WAIT_L(0); PG8_BAR; PG8_MMA(0, 0, At, B0); PG8_MMA(0, 1, At, B1); PG8_BAR; PG8_SCHED;
            PG8_LDA(At, 1, 1); PG8_STAGE(PG8_SB(1, 0), b3, voffB); PG8_STAGE(PG8_SB(1, 1), b3 + hstep, voffB); PG8_STAGE(PG8_SA(1, 0), a3, voffA);
            PG8_WAIT_V(8); PG8_WAIT_L(0); PG8_BAR; PG8_MMA(1, 0, At, B0); PG8_MMA(1, 1, At, B1); PG8_BAR; PG8_SCHED;
            } else {
            PG8_LDB(B0, 0, 0); PG8_SCHED; PG8_LDA(At, 0, 0); PG8_STAGE(PG8_SA(1, 1), a1 + hstep, voffA);
            PG8_WAIT_L(8); PG8_BAR; PG8_WAIT_L(0); PG8_MMA(0, 0, At, B0); PG8_BAR; PG8_SCHED;
            PG8_LDB(B1, 0, 1); PG8_STAGE(PG8_SB(0, 0), b2, voffB);
            PG8_BAR; PG8_WAIT_L(0); PG8_MMA(0, 1, At, B1); PG8_BAR;
            PG8_LDA(At, 0, 1); PG8_STAGE(PG8_SA(0, 0), a2, voffA);
            PG8_BAR; PG8_WAIT_L(0); PG8_MMA(1, 0, At, B0); PG8_BAR; PG8_SCHED;
            PG8_STAGE(PG8_SB(0, 1), b2 + hstep, voffB);
            PG8_WAIT_V(6); PG8_BAR; PG8_MMA(1, 1, At, B1); PG8_BAR;
            PG8_LDB(B0, 1, 0); PG8_SCHED; PG8_LDA(At, 1, 0); PG8_STAGE(PG8_SA(0, 1), a2 + hstep, voffA);
            PG8_WAIT_L(8); PG8_BAR; PG8_WAIT_L(0); PG8_MMA(0, 0, At, B0); PG8_BAR; PG8_SCHED;
            PG8_LDB(B1, 1, 1); PG8_STAGE(PG8_SB(1, 0), b3, voffB);
            PG8_BAR; PG8_WAIT_L(0); PG8_MMA(0, 1, At, B1); PG8_BAR;
            PG8_LDA(At, 1, 1); PG8_STAGE(PG8_SA(1, 0), a3, voffA);
            PG8_BAR; PG8_WAIT_L(0); PG8_MMA(1, 0, At, B0); PG8_BAR; PG8_SCHED;
            PG8_STAGE(PG8_SB(1, 1), b3 + hstep, voffB);
            PG8_WAIT_V(6); PG8_BAR; PG8_MMA(1, 1, At, B1); PG8_BAR;
            }
        }
        if constexpr (ALIGN_EPI) { if (wr == 0) PG8_BAR; }
        if constexpr (!Epi::AFTER_DRAIN) { E(acc, cur, wr, wc, fr, fq); S.done(cur); }
        if (!has_next) break;
#pragma unroll
        for (int a = 0; a < 2; ++a)
#pragma unroll
            for (int b = 0; b < 2; ++b)
#pragma unroll
                for (int m = 0; m < 4; ++m)
#pragma unroll
                    for (int n = 0; n < 2; ++n) acc[a][b][m][n] = (f32x4){0.f, 0.f, 0.f, 0.f};
        cur = nxt; cA = nA; cB = nB; ++ui;
        if constexpr (ALIGN_EPI) { if (wr == 1) PG8_BAR; }
    }
    PG8_WAIT_V(0);
    if constexpr (!ALIGN_EPI) { if (wr == 0) PG8_BAR; }
    PG8_BAR;
    if constexpr (Epi::AFTER_DRAIN) { E.fused(acc, cur, wr, wc, fr, fq, lds, wid, lane); S.done(cur); }
#undef PG8_SA
#undef PG8_SB
#undef PG8_STAGE
#undef PG8_LDA
#undef PG8_LDB
#undef PG8_MMA
#undef PG8_WAIT_V
#undef PG8_WAIT_L
#undef PG8_BAR
#undef PG8_SCHED
}
}
#ifndef PG8_SP2
#define PG8_SP2 true
#endif
#ifndef PG8_ALIGN
#define PG8_ALIGN true
#endif
#define GAS __attribute__((address_space(1)))
#define LAS __attribute__((address_space(3)))
typedef unsigned short bf16;
typedef unsigned v4u __attribute__((ext_vector_type(4)));
typedef float f32x4 __attribute__((ext_vector_type(4)));
typedef short bf16x8 __attribute__((ext_vector_type(8)));
typedef GAS unsigned gu32;
typedef GAS unsigned long long gu64;
#define RLX_AGENT __ATOMIC_RELAXED, __HIP_MEMORY_SCOPE_AGENT
#define LDS_WAIT() asm volatile("s_waitcnt lgkmcnt(0)" ::: "memory")
#define VM_WAIT() asm volatile("s_waitcnt vmcnt(0)" ::: "memory")
__device__ __forceinline__ unsigned long long rt() { return __builtin_amdgcn_s_memrealtime(); }
__device__ __forceinline__ unsigned f2bf(float f) { unsigned u = __builtin_bit_cast(unsigned, f); return (u + 0x7fffu + ((u >> 16) & 1u)) >> 16; }
__device__ __forceinline__ unsigned pk2(float lo, float hi) { return f2bf(lo) | (f2bf(hi) << 16); }

#define XB_TMO      128
#define XB_XCNT(j)  (256  + 64 * (j))
#define XB_XSUB(j)  (1280 + 64 * (j))
#define XB_XGEN(j)  (2304 + 64 * (j))
#define XB_TOP      3328
#define XB_TOPGEN   3392
#define XCD_BAR_WORDS 3456
#define XB_SPIN_CAP (1u << 18)

__device__ __forceinline__ unsigned xb_ld(unsigned* p)              { return __hip_atomic_load(p, __ATOMIC_RELAXED, __HIP_MEMORY_SCOPE_AGENT); }
__device__ __forceinline__ unsigned xb_add(unsigned* p, unsigned v) { return __hip_atomic_fetch_add(p, v, __ATOMIC_RELAXED, __HIP_MEMORY_SCOPE_AGENT); }
__device__ __forceinline__ unsigned xb_xcc_id() { return (unsigned)__builtin_amdgcn_s_getreg((3 << 11) | 20) & 0xFu; }
#define XB_SPIN(cond, bar) do { unsigned _sp = 0; while (cond) { __builtin_amdgcn_s_sleep(1); \
    if ((++_sp & 255u) == 0u) { if (xb_ld(&(bar)[XB_TMO])) break; if (_sp > XB_SPIN_CAP) { atomicAdd(&(bar)[XB_TMO], 1u); break; } } } } while (0)

struct XcdBarrier {
    unsigned* bar; unsigned x;
    volatile LAS unsigned* st;
};

__device__ __forceinline__ XcdBarrier xcd_barrier_post(unsigned* bar, volatile LAS unsigned* st) {
    XcdBarrier b; b.bar = bar; b.x = xb_xcc_id(); b.st = st;
    if (threadIdx.x == 0) (void)xb_add(&bar[XB_XCNT(b.x)], 1u);
    return b;
}
__device__ __forceinline__ void xcd_barrier_complete(unsigned* bar, unsigned x, unsigned& nloc, unsigned& nx) {
    const unsigned G = gridDim.x * gridDim.y * gridDim.z;
    unsigned sum, cnt, mine, sp = 0u;
    for (;;) {
        sum = 0u; cnt = 0u; mine = 0u;
#pragma unroll
        for (unsigned j = 0; j < 16; ++j) { const unsigned c = xb_ld(&bar[XB_XCNT(j)]); sum += c; cnt += (c > 0u) ? 1u : 0u; mine = (j == x) ? c : mine; }
        if (sum == G) break;
        __builtin_amdgcn_s_sleep(1);
        if ((++sp & 255u) == 0u) { if (xb_ld(&bar[XB_TMO])) break; if (sp > XB_SPIN_CAP) { atomicAdd(&bar[XB_TMO], 1u); break; } }
    }
    nloc = mine > 0u ? mine : 1u; nx = cnt > 0u ? cnt : 1u;
}

__device__ __forceinline__ void xcd_barrier(const XcdBarrier& b) {
    asm volatile("s_waitcnt vmcnt(0)" ::: "memory");
    __syncthreads();
    if (threadIdx.x == 0) {
        unsigned* bar = b.bar;
        __builtin_amdgcn_s_waitcnt(0);
        unsigned nloc = b.st[0], nx = b.st[1];
        if (nloc == 0u) { xcd_barrier_complete(bar, b.x, nloc, nx); b.st[0] = nloc; b.st[1] = nx; }
        const unsigned old = xb_add(&bar[XB_XSUB(b.x)], 1u);
        const unsigned gen = old / nloc;
        if (old + 1u == (gen + 1u) * nloc) {
            __builtin_amdgcn_fence(__ATOMIC_RELEASE, "agent");
            asm volatile("s_waitcnt vmcnt(0)" ::: "memory");
            const unsigned og = xb_add(&bar[XB_TOP], 1u);
            const unsigned tg = og / nx;
            if (og + 1u == (tg + 1u) * nx) xb_add(&bar[XB_TOPGEN], 1u);
            else XB_SPIN(xb_ld(&bar[XB_TOPGEN]) == tg, bar);
            __builtin_amdgcn_fence(__ATOMIC_ACQUIRE, "agent");
            xb_add(&bar[XB_XGEN(b.x)], 1u);
            asm volatile("s_waitcnt vmcnt(0)" ::: "memory");
        } else {
            XB_SPIN(xb_ld(&bar[XB_XGEN(b.x)]) == gen, bar);
            __builtin_amdgcn_fence(__ATOMIC_ACQUIRE, "agent");
            asm volatile("s_waitcnt vmcnt(0)" ::: "memory");
        }
    }
    __syncthreads();
}

constexpr int NWAVES = 8;
constexpr int DM = 1024, NBATCH = 8, SEQ = 2048, M = NBATCH * SEQ;
constexpr int AW = 2048, AG = 8, AGD = 256, CH = 128;
constexpr int BW = 1536, BH = 12, BD = 128;
constexpr size_t MiB = 1u << 20;
constexpr size_t WS_CTL = 0, CTL_ZERO_BYTES = 1 * MiB;
constexpr size_t WS_W1UG = 1 * MiB, WS_W1V = 9 * MiB, WS_W2 = 13 * MiB, WS_W3 = 17 * MiB, WS_W4 = 23 * MiB, WS_WG = 26 * MiB;
constexpr size_t WS_RS0 = 27 * MiB, WS_SS1 = 28 * MiB, WS_ST = 29 * MiB;
constexpr size_t WS_XB16 = 32 * MiB;
constexpr size_t WS_P = 64 * MiB;
constexpr size_t WS_VT = 128 * MiB;
constexpr size_t WS_END = 192 * MiB;
constexpr int CW_BAR = 4096;
constexpr int RING_OFF = 0, RING_BYTES = 131072;
constexpr int LDSCTL_OFF = RING_BYTES, MISC_OFF = LDSCTL_OFF + 320;
constexpr int LDS_BYTES = 147456;

struct Frame {
    LAS unsigned char* lds;
    volatile LAS unsigned* MISC;
    gu32* ctl;
    int tid, lane, wave;
    int vcu, G;
    const float *x, *norm_w, *a_w_in, *a_ln_w, *a_ln_b, *a_w_s, *a_b_s, *a_w_out, *b_w_in, *b_conv_w, *b_conv_b, *b_gate_a_w, *b_gate_a_b, *b_gate_x_w, *b_gate_x_b, *b_lambda, *b_w_out, *norm_f_w;
    float* out;
    bf16 *W1UG, *W1V, *W2, *W3, *W4, *WGT;
    float *RS0, *SS1, *ST;
    bf16 *XB16, *P, *VT, *XBC, *SG;
};

__device__ __forceinline__ float wave_sum(float v) {
#pragma unroll
    for (int o = 1; o < 64; o <<= 1) v += __shfl_xor(v, o);
    return v;
}
__device__ __forceinline__ float bf2f(unsigned short b) { return __uint_as_float(((unsigned)b) << 16); }
__device__ __forceinline__ void p0_tr(const float* W, int ldw, int col0, int k0, const float* ks, bf16* WT, int Kd, LAS float* scr, int lane) {
#pragma unroll 8
    for (int i = 0; i < 32; ++i) { const int kk = 2 * i + (lane >> 5); float v = W[(size_t)(k0 + kk) * ldw + col0 + (lane & 31)]; if (ks) v *= ks[k0 + kk]; scr[kk * 33 + (lane & 31)] = v; }
    LDS_WAIT(); asm volatile("" ::: "memory");
    const int c = lane & 7;
#pragma unroll
    for (int j = 0; j < 4; ++j) { const int n = (lane >> 3) + 8 * j; const LAS float* s = scr + (8 * c) * 33 + n;
        v4u o; o.x = pk2(s[0 * 33], s[1 * 33]); o.y = pk2(s[2 * 33], s[3 * 33]); o.z = pk2(s[4 * 33], s[5 * 33]); o.w = pk2(s[6 * 33], s[7 * 33]);
        *(GAS v4u*)(WT + (size_t)n * Kd + k0 + 8 * c) = o; }
    LDS_WAIT(); asm volatile("" ::: "memory");
}
__device__ __forceinline__ void p0_prologue(Frame& F) {
    LAS float* scr = (LAS float*)(F.lds + RING_OFF + F.wave * 16384);
    const int gw = F.vcu * NWAVES + F.wave, NGW = F.G * NWAVES;
    constexpr int I_W1 = 16 * 192, I_W2 = 32 * 32, I_W3 = 16 * 96, I_W4 = 24 * 32, I_G = 24 * 8;
    constexpr int NITEMS = I_W1 + I_W2 + I_W3 + I_W4 + I_G;
    for (int it = gw; it < NITEMS; it += NGW) {
        int r = it;
        if (r < I_W1) { const int kb = r / 192, nb = r % 192; bf16* dst;
            if (nb < 64) dst = F.W1UG + (size_t)(256 * (nb >> 2) + 32 * (nb & 3)) * DM;
            else if (nb < 128) dst = F.W1V + (size_t)(32 * (nb - 64)) * DM;
            else { const int q = nb - 128; dst = F.W1UG + (size_t)(256 * (q >> 2) + 128 + 32 * (q & 3)) * DM; }
            p0_tr(F.a_w_in, 3 * AW, 32 * nb, 64 * kb, F.norm_w, dst, DM, scr, F.lane); continue; } r -= I_W1;
        if (r < I_W2) { const int kb = r / 32, nb = r % 32; p0_tr(F.a_w_out, DM, 32 * nb, 64 * kb, nullptr, F.W2 + (size_t)(32 * nb) * AW, AW, scr, F.lane); continue; } r -= I_W2;
        if (r < I_W3) { const int kb = r / 96, nb = r % 96; p0_tr(F.b_w_in, 2 * BW, 32 * nb, 64 * kb, F.norm_w + DM, F.W3 + (size_t)(32 * nb) * DM, DM, scr, F.lane); continue; } r -= I_W3;
        if (r < I_W4) { const int kb = r / 32, nb = r % 32; p0_tr(F.b_w_out, DM, 32 * nb, 64 * kb, nullptr, F.W4 + (size_t)(32 * nb) * BW, BW, scr, F.lane); continue; } r -= I_W4;
        { const int mat = r / 8, kb = (r % 8) / 4, nb = r % 4;
          const float* src = (mat < 12 ? F.b_gate_a_w : F.b_gate_x_w) + (size_t)(mat % 12) * BD * BD;
          p0_tr(src, BD, 32 * nb, 64 * kb, nullptr, F.WGT + (size_t)mat * BD * BD + (size_t)(32 * nb) * BD, BD, scr, F.lane); }
    }
    for (int m = gw; m < M; m += NGW) {
        const GAS f32x4* xr = (const GAS f32x4*)(F.x + (size_t)m * DM) + F.lane;
        f32x4 v[4]; float s = 0.f;
#pragma unroll
        for (int j = 0; j < 4; ++j) { v[j] = xr[64 * j]; s += (v[j].x * v[j].x + v[j].y * v[j].y) + (v[j].z * v[j].z + v[j].w * v[j].w); }
        s = wave_sum(s);
        if (F.lane == 0) F.RS0[m] = 1.0f / sqrtf(s * (1.0f / DM) + 1e-6f);
        GAS unsigned long long* o8 = (GAS unsigned long long*)(F.XB16 + (size_t)m * DM) + F.lane;
#pragma unroll
        for (int j = 0; j < 4; ++j) o8[64 * j] = (unsigned long long)pk2(v[j].x, v[j].y) | ((unsigned long long)pk2(v[j].z, v[j].w) << 32);
    }
}

__device__ __forceinline__ void sgu_unit(Frame& F, int chunk, int g) {
    const int tid = F.tid, lane = F.lane, w = F.wave, fr = lane & 15, fq = lane >> 4;
    LAS unsigned char* img = F.lds + RING_OFF;
    LAS float* tab = (LAS float*)(F.lds + RING_OFF + 32768);
    bf16x8 Af[2][4];
    { const bf16* vt = F.VT + (size_t)(g * AGD + 32 * w + fr) * M + chunk * CH + 8 * fq;
#pragma unroll
      for (int mi = 0; mi < 2; ++mi)
#pragma unroll
          for (int kk = 0; kk < 4; ++kk) Af[mi][kk] = *(const GAS bf16x8*)(vt + (size_t)(16 * mi) * M + 32 * kk); }
    if (tid < CH) {
        const int token = chunk * CH + tid; float S = 0.f, Q = 0.f;
#pragma unroll
        for (int sl = 0; sl < 16; ++sl) { const pg8::f32x2 pq = *(const GAS pg8::f32x2*)(F.ST + ((size_t)sl * M + token) * 2); S += pq.x; Q += pq.y; }
        const float mean = S * (1.0f / AW), var = Q * (1.0f / AW) - mean * mean;
        tab[tid] = mean; tab[128 + tid] = 1.0f / sqrtf(var + 1e-5f); tab[512 + tid] = F.a_b_s[g * CH + tid];
    }
    __syncthreads();
    { const int t = tid >> 2, sq = tid & 3; const float* wrow = F.a_w_s + ((size_t)g * CH + t) * CH + 32 * sq; float c1 = 0.f, c2 = 0.f;
#pragma unroll
      for (int q = 0; q < 4; ++q) { const int s0 = 32 * sq + 8 * q;
          const f32x4 w0 = *(const GAS f32x4*)(wrow + 8 * q), w1 = *(const GAS f32x4*)(wrow + 8 * q + 4);
          const float wv[8] = {w0.x, w0.y, w0.z, w0.w, w1.x, w1.y, w1.z, w1.w}; unsigned bits[8];
#pragma unroll
          for (int j = 0; j < 8; ++j) { const float wm = (s0 + j <= t) ? wv[j] : 0.f; c2 += wm; bits[j] = f2bf(wm * tab[128 + s0 + j]); c1 += tab[s0 + j] * __uint_as_float(bits[j] << 16); }
          v4u o; o.x = bits[0] | (bits[1] << 16); o.y = bits[2] | (bits[3] << 16); o.z = bits[4] | (bits[5] << 16); o.w = bits[6] | (bits[7] << 16);
          *(LAS v4u*)(img + t * 256 + (((4 * sq + q) ^ (t & 15)) * 16)) = o; }
      c1 += __shfl_xor(c1, 1); c1 += __shfl_xor(c1, 2); c2 += __shfl_xor(c2, 1); c2 += __shfl_xor(c2, 2);
      if (sq == 0) { tab[256 + t] = c1; tab[384 + t] = c2; } }
    __syncthreads();
    f32x4 acc[2][8];
#pragma unroll
    for (int mi = 0; mi < 2; ++mi)
#pragma unroll
        for (int nj = 0; nj < 8; ++nj) acc[mi][nj] = (f32x4){0.f, 0.f, 0.f, 0.f};
#pragma unroll
    for (int nj = 0; nj < 8; ++nj)
#pragma unroll
        for (int kk = 0; kk <= nj / 2; ++kk) {
            const bf16x8 Bf = *(const LAS bf16x8*)(img + (16 * nj + fr) * 256 + (((4 * kk + fq) ^ fr) * 16));
#pragma unroll
            for (int mi = 0; mi < 2; ++mi) acc[mi][nj] = __builtin_amdgcn_mfma_f32_16x16x32_bf16(Af[mi][kk], Bf, acc[mi][nj], 0, 0, 0);
        }
#pragma unroll
    for (int mi = 0; mi < 2; ++mi) {
        const int col0 = g * AGD + 32 * w + 16 * mi + 4 * fq;
        const f32x4 lw = *(const GAS f32x4*)(F.a_ln_w + col0), lb = *(const GAS f32x4*)(F.a_ln_b + col0);
#pragma unroll
        for (int nj = 0; nj < 8; ++nj) {
            const int tl = 16 * nj + fr; const float c1t = tab[256 + tl], c2t = tab[384 + tl], bst = tab[512 + tl];
            GAS pg8::u32x2* pp = (GAS pg8::u32x2*)(F.P + (size_t)(chunk * CH + tl) * AW + col0);
            const pg8::u32x2 pv = *pp;
            const float p0 = pg8::bf_lo(pv.x), p1 = pg8::bf_hi(pv.x), p2 = pg8::bf_lo(pv.y), p3 = pg8::bf_hi(pv.y);
            const f32x4 a = acc[mi][nj];
            const float y0 = p0 * (lw.x * (a.x - c1t) + lb.x * c2t + bst), y1 = p1 * (lw.y * (a.y - c1t) + lb.y * c2t + bst);
            const float y2 = p2 * (lw.z * (a.z - c1t) + lb.z * c2t + bst), y3 = p3 * (lw.w * (a.w - c1t) + lb.w * c2t + bst);
            pg8::u32x2 o; o.x = pk2(y0, y1); o.y = pk2(y2, y3); *pp = o;
        }
    }
    __syncthreads();
}

__device__ __forceinline__ void rglru_unit(Frame& F, int b, int h) {
    const int tid = F.tid, lane = F.lane, w = F.wave, fr = lane & 15, fq = lane >> 4;
    LAS unsigned char* img = F.lds + RING_OFF;
    bf16x8 WA[4], WX[4];
    { const bf16* wa = F.WGT + ((size_t)h * BD + 16 * w + fr) * BD + 8 * fq; const bf16* wx = F.WGT + ((size_t)(BH + h) * BD + 16 * w + fr) * BD + 8 * fq;
#pragma unroll
      for (int kk = 0; kk < 4; ++kk) { WA[kk] = *(const GAS bf16x8*)(wa + 32 * kk); WX[kk] = *(const GAS bf16x8*)(wx + 32 * kk); } }
    const int chl = h * BD + 16 * w + 4 * fq;
    const f32x4 ba = *(const GAS f32x4*)(F.b_gate_a_b + chl), bx = *(const GAS f32x4*)(F.b_gate_x_b + chl), lam = *(const GAS f32x4*)(F.b_lambda + chl);
    float nsp[4];
#pragma unroll
    for (int e = 0; e < 4; ++e) { const float nl = -lam[e]; const float sp = fmaxf(nl, 0.f) + log1pf(expf(-fabsf(nl))); nsp[e] = -8.0f * 1.442695041f * sp; }
    const int cv = tid & 15, tg = tid >> 4; const int chc = h * BD + 8 * cv;
    float cw[4][8], cb[8];
#pragma unroll
    for (int k = 0; k < 4; ++k) { const f32x4 a0 = *(const GAS f32x4*)(F.b_conv_w + k * BW + chc), a1 = *(const GAS f32x4*)(F.b_conv_w + k * BW + chc + 4);
        cw[k][0] = a0.x; cw[k][1] = a0.y; cw[k][2] = a0.z; cw[k][3] = a0.w; cw[k][4] = a1.x; cw[k][5] = a1.y; cw[k][6] = a1.z; cw[k][7] = a1.w; }
    { const f32x4 a0 = *(const GAS f32x4*)(F.b_conv_b + chc), a1 = *(const GAS f32x4*)(F.b_conv_b + chc + 4);
      cb[0] = a0.x; cb[1] = a0.y; cb[2] = a0.z; cb[3] = a0.w; cb[4] = a1.x; cb[5] = a1.y; cb[6] = a1.z; cb[7] = a1.w; }
    float hin[4] = {0.f, 0.f, 0.f, 0.f};
    for (int chunk = 0; chunk < SEQ / CH; ++chunk) {
        const int t0 = chunk * CH;
        { v4u xr[7];
#pragma unroll
          for (int i = 0; i < 7; ++i) { const int t = t0 + 4 * tg - 3 + i;
              xr[i] = (t >= 0) ? *(const GAS v4u*)(F.XBC + (size_t)(b * SEQ + t) * BW + chc) : (v4u){0u, 0u, 0u, 0u}; }
#pragma unroll
          for (int i = 0; i < 4; ++i) { float o[8];
#pragma unroll
              for (int c = 0; c < 8; ++c) o[c] = cb[c];
#pragma unroll
              for (int k = 0; k < 4; ++k) { const v4u q = xr[i + k]; const unsigned qq[4] = {q.x, q.y, q.z, q.w};
#pragma unroll
                  for (int c2 = 0; c2 < 4; ++c2) { o[2 * c2] = fmaf(cw[k][2 * c2], pg8::bf_lo(qq[c2]), o[2 * c2]); o[2 * c2 + 1] = fmaf(cw[k][2 * c2 + 1], pg8::bf_hi(qq[c2]), o[2 * c2 + 1]); } }
              v4u pk; pk.x = pk2(o[0], o[1]); pk.y = pk2(o[2], o[3]); pk.z = pk2(o[4], o[5]); pk.w = pk2(o[6], o[7]);
              const int row = 4 * tg + i; *(LAS v4u*)(img + row * 256 + ((cv ^ (row & 15)) * 16)) = pk; } }
        __syncthreads();
        for (int nb = 0; nb < 8; ++nb) {
            const int row = 16 * nb + fr;
            f32x4 aA = {0.f, 0.f, 0.f, 0.f}, aX = {0.f, 0.f, 0.f, 0.f};
#pragma unroll
            for (int kk = 0; kk < 4; ++kk) { const bf16x8 Bf = *(const LAS bf16x8*)(img + row * 256 + (((4 * kk + fq) ^ fr) * 16));
                aA = __builtin_amdgcn_mfma_f32_16x16x32_bf16(WA[kk], Bf, aA, 0, 0, 0); aX = __builtin_amdgcn_mfma_f32_16x16x32_bf16(WX[kk], Bf, aX, 0, 0, 0); }
            const pg8::u32x2 xq = *(const LAS pg8::u32x2*)(img + row * 256 + (((2 * w + (fq >> 1)) ^ fr) * 16) + 8 * (fq & 1));
            const float xcv[4] = {pg8::bf_lo(xq.x), pg8::bf_hi(xq.x), pg8::bf_lo(xq.y), pg8::bf_hi(xq.y)};
            const size_t goff = (size_t)(b * SEQ + t0 + row) * BW + chl;
            const pg8::u32x2 sq = *(const GAS pg8::u32x2*)(F.SG + goff);
            const float sgv[4] = {pg8::bf_lo(sq.x), pg8::bf_hi(sq.x), pg8::bf_lo(sq.y), pg8::bf_hi(sq.y)};
            float av[4], bv[4];
#pragma unroll
            for (int e = 0; e < 4; ++e) {
                const float rg = __builtin_amdgcn_rcpf(1.0f + __builtin_amdgcn_exp2f((aA[e] + ba[e]) * -1.442695041f));
                const float ig = __builtin_amdgcn_rcpf(1.0f + __builtin_amdgcn_exp2f((aX[e] + bx[e]) * -1.442695041f));
                const float a = __builtin_amdgcn_exp2f(rg * nsp[e]);
                av[e] = a; bv[e] = __builtin_amdgcn_sqrtf(fmaxf(1.0f - a * a, 0.f)) * (ig * xcv[e]);
            }
#pragma unroll
            for (int d = 1; d < 16; d <<= 1) {
#pragma unroll
                for (int e = 0; e < 4; ++e) { const float ap = __shfl_up(av[e], d, 16), bp = __shfl_up(bv[e], d, 16);
                    if (fr >= d) { bv[e] = fmaf(av[e], bp, bv[e]); av[e] = av[e] * ap; } }
            }
            float hv[4];
#pragma unroll
            for (int e = 0; e < 4; ++e) { hv[e] = fmaf(av[e], hin[e], bv[e]); hin[e] = __shfl(hv[e], (lane & 48) | 15); }
            pg8::u32x2 o; o.x = pk2(hv[0] * sgv[0], hv[1] * sgv[1]); o.y = pk2(hv[2] * sgv[2], hv[3] * sgv[3]);
            *(GAS pg8::u32x2*)(F.SG + goff) = o;
        }
        __syncthreads();
    }
}

struct Args { const float* in[18]; float* out; unsigned char* ws; int ph_lo, ph_hi; };
constexpr int N_PHASES = 8;
__global__ void __launch_bounds__(NWAVES * 64, 2) mk_fwd(Args args) {
    extern __shared__ __attribute__((aligned(16))) unsigned char lds[];
    Frame F;
    F.lds = (LAS unsigned char*)lds;
    F.MISC = (volatile LAS unsigned*)(F.lds + MISC_OFF);
    F.tid = threadIdx.x; F.lane = F.tid & 63; F.wave = __builtin_amdgcn_readfirstlane(F.tid >> 6);
    F.G = gridDim.x; { const int bx = blockIdx.x; F.vcu = (F.G % 8 == 0) ? (bx % 8) * (F.G / 8) + bx / 8 : bx; }
    unsigned char* ws = args.ws;
    F.ctl = (gu32*)(ws + WS_CTL);
    F.x = args.in[0]; F.norm_w = args.in[1]; F.a_w_in = args.in[2]; F.a_ln_w = args.in[3]; F.a_ln_b = args.in[4]; F.a_w_s = args.in[5]; F.a_b_s = args.in[6]; F.a_w_out = args.in[7];
    F.b_w_in = args.in[8]; F.b_conv_w = args.in[9]; F.b_conv_b = args.in[10]; F.b_gate_a_w = args.in[11]; F.b_gate_a_b = args.in[12]; F.b_gate_x_w = args.in[13]; F.b_gate_x_b = args.in[14];
    F.b_lambda = args.in[15]; F.b_w_out = args.in[16]; F.norm_f_w = args.in[17]; F.out = args.out;
    F.W1UG = (bf16*)(ws + WS_W1UG); F.W1V = (bf16*)(ws + WS_W1V); F.W2 = (bf16*)(ws + WS_W2); F.W3 = (bf16*)(ws + WS_W3); F.W4 = (bf16*)(ws + WS_W4); F.WGT = (bf16*)(ws + WS_WG);
    F.RS0 = (float*)(ws + WS_RS0); F.SS1 = (float*)(ws + WS_SS1); F.ST = (float*)(ws + WS_ST);
    F.XB16 = (bf16*)(ws + WS_XB16); F.P = (bf16*)(ws + WS_P); F.VT = (bf16*)(ws + WS_VT); F.XBC = (bf16*)(ws + WS_P); F.SG = (bf16*)(ws + WS_VT);
    for (int u = F.tid; u < (LDS_BYTES - LDSCTL_OFF) / 4; u += NWAVES * 64) ((LAS unsigned*)(F.lds + LDSCTL_OFF))[u] = 0u;
    __syncthreads();
    const int lo = args.ph_lo, hi = args.ph_hi;
    const bool use_bar = (hi - lo) > 1;
    XcdBarrier bar; bar.bar = (unsigned*)(F.ctl + CW_BAR); bar.x = 0; bar.st = nullptr;
    if (use_bar) bar = xcd_barrier_post((unsigned*)(F.ctl + CW_BAR), F.MISC + 8);
#define IN(k) (lo <= (k) && (k) < hi)
#define BOTH(k) (IN(k) && IN((k) + 1))
    if (IN(0)) { p0_prologue(F); if (BOTH(0)) xcd_barrier(bar); }
    if (IN(1)) {
        { pg8::Gemm g{F.XB16, F.W1UG, M, 2 * AW, DM}; pg8::StaticOrder S; S.init(M, 2 * AW, F.G, (int)blockIdx.x);
          pg8::EpiUG E{F.P, F.RS0};
          pg8::gemm_phase<pg8::EpiUG, pg8::StaticOrder, PG8_ALIGN, PG8_SP2>(F.lds + RING_OFF, g, S, E); }
        { pg8::Gemm g{F.W1V, F.XB16, AW, M, DM}; pg8::StaticOrder S; S.init(AW, M, F.G, (int)blockIdx.x);
          pg8::EpiVT E{F.VT, F.RS0, F.ST, M};
          pg8::gemm_phase<pg8::EpiVT, pg8::StaticOrder, PG8_ALIGN, PG8_SP2>(F.lds + RING_OFF, g, S, E); }
        if (BOTH(1)) xcd_barrier(bar);
    }
    if (IN(2)) {
        for (int u = F.vcu; u < (M / CH) * AG; u += F.G) sgu_unit(F, u / AG, u % AG);
        if (BOTH(2)) xcd_barrier(bar);
    }
    if (IN(3)) {
        pg8::Gemm g{F.P, F.W2, M, DM, AW}; pg8::StaticOrder S; S.init(M, DM, F.G, (int)blockIdx.x);
        pg8::EpiRes1 E{F.x, F.out, F.XB16, F.SS1};
        pg8::gemm_phase<pg8::EpiRes1, pg8::StaticOrder, PG8_ALIGN, PG8_SP2>(F.lds + RING_OFF, g, S, E);
        if (BOTH(3)) xcd_barrier(bar);
    }
    if (IN(4)) {
        pg8::Gemm g{F.XB16, F.W3, M, 2 * BW, DM}; pg8::StaticOrder S; S.init(M, 2 * BW, F.G, (int)blockIdx.x);
        pg8::EpiXG E{F.XBC, F.SG, F.SS1};
        pg8::gemm_phase<pg8::EpiXG, pg8::StaticOrder, PG8_ALIGN, PG8_SP2>(F.lds + RING_OFF, g, S, E);
        if (BOTH(4)) xcd_barrier(bar);
    }
    if (IN(5)) {
        for (int u = F.vcu; u < NBATCH * BH; u += F.G) rglru_unit(F, u / BH, u % BH);
        if (BOTH(5)) xcd_barrier(bar);
    }
    if (IN(6)) {
        pg8::Gemm g{F.SG, F.W4, M, DM, BW}; pg8::StaticOrder S; S.init(M, DM, F.G, (int)blockIdx.x);
        pg8::EpiRes2 E{F.out};
        pg8::gemm_phase<pg8::EpiRes2, pg8::StaticOrder, PG8_ALIGN, PG8_SP2>(F.lds + RING_OFF, g, S, E);
        if (BOTH(6)) xcd_barrier(bar);
    }
    if (IN(7)) {
        const int gw = F.vcu * NWAVES + F.wave, NGW = F.G * NWAVES;
        for (int m = gw; m < M; m += NGW) {
            GAS f32x4* xr = (GAS f32x4*)(F.out + (size_t)m * DM) + F.lane;
            f32x4 v[4]; float s = 0.f;
#pragma unroll
            for (int j = 0; j < 4; ++j) { v[j] = xr[64 * j]; s += (v[j].x * v[j].x + v[j].y * v[j].y) + (v[j].z * v[j].z + v[j].w * v[j].w); }
            s = wave_sum(s);
            const float rstd = 1.0f / sqrtf(s * (1.0f / DM) + 1e-6f);
#pragma unroll
            for (int j = 0; j < 4; ++j) { const f32x4 ww = *((const GAS f32x4*)F.norm_f_w + F.lane + 64 * j); xr[64 * j] = v[j] * rstd * ww; }
        }
    }
#undef IN
#undef BOTH
}

#ifndef MK_N_LAUNCHES
#define MK_N_LAUNCHES 1
#endif
extern "C" void kernel_launch(void* const* d_in, const int* in_sizes, int n_in, void* d_out, int out_size, void* d_ws, size_t ws_size, hipStream_t stream) {
    static int grid = 0;
    if (grid == 0) {
        if (n_in != 18 || in_sizes[0] != M * DM || out_size != M * DM || ws_size < WS_END) { fprintf(stderr, "kernel_launch: unexpected shapes (n_in %d, in0 %d, out %d, ws %zu); nothing launched\n", n_in, n_in > 0 ? in_sizes[0] : -1, out_size, ws_size); grid = -1; return; }
        int dev = 0, cus = 0, per_cu = 0;
        if (hipGetDevice(&dev) != hipSuccess || hipDeviceGetAttribute(&cus, hipDeviceAttributeMultiprocessorCount, dev) != hipSuccess) { fprintf(stderr, "kernel_launch: device query failed\n"); grid = -1; return; }
        if (hipFuncSetAttribute((const void*)mk_fwd, hipFuncAttributeMaxDynamicSharedMemorySize, LDS_BYTES) != hipSuccess) { fprintf(stderr, "kernel_launch: hipFuncSetAttribute failed\n"); grid = -1; return; }
        if (hipOccupancyMaxActiveBlocksPerMultiprocessor(&per_cu, (const void*)mk_fwd, NWAVES * 64, LDS_BYTES) != hipSuccess || per_cu < 1)
            fprintf(stderr, "kernel_launch: note: occupancy query reports %d workgroups per CU\n", per_cu);
        (void)hipGetLastError();
        grid = cus;
    }
    if (grid < 0) return;
    if (hipMemsetAsync((char*)d_ws + WS_CTL, 0, CTL_ZERO_BYTES, stream) != hipSuccess) { fprintf(stderr, "kernel_launch: hipMemsetAsync failed\n"); return; }
    Args a{};
    for (int i = 0; i < 18; ++i) a.in[i] = (const float*)d_in[i];
    a.out = (float*)d_out; a.ws = (unsigned char*)d_ws;
#if MK_N_LAUNCHES == 1
    a.ph_lo = 0; a.ph_hi = N_PHASES;
    hipLaunchKernelGGL(mk_fwd, dim3(grid), dim3(NWAVES * 64), LDS_BYTES, stream, a);
#else
    for (int p = 0; p < N_PHASES; ++p) { a.ph_lo = p; a.ph_hi = p + 1; hipLaunchKernelGGL(mk_fwd, dim3(grid), dim3(NWAVES * 64), LDS_BYTES, stream, a); }
#endif
    const hipError_t le = hipPeekAtLastError();
    if (le != hipSuccess) fprintf(stderr, "kernel_launch: launch failed: %s (grid %d)\n", hipGetErrorName(le), grid);
}
```

```cpp
#include <hip/hip_runtime.h>
#include <cstdio>
#include <cstdint>
namespace pg8 {
#define PG8_LAS __attribute__((address_space(3)))
typedef unsigned short bf16_t;
typedef short bf16x8 __attribute__((ext_vector_type(8)));
typedef float f32x4 __attribute__((ext_vector_type(4)));
typedef unsigned u32x4 __attribute__((ext_vector_type(4)));
constexpr int BM = 256, BK = 64, HALF = 128, HTB = HALF * BK * 2  , STAGE_BYTES = 8 * HTB, NXCD = 8, WGM = 8;

__host__ __device__ __forceinline__ int lds_byte(int r, int c) { const int st = (r >> 4) * 2 + (c >> 5), rr = r & 15, cc = c & 31, ob = rr * 64 + cc * 2; return st * 1024 + (ob ^ (((ob >> 9) & 1) << 5)); }
__host__ __device__ __forceinline__ void stage_rc(int b, int& R, int& C) { const int st = b / 1024, sb = b % 1024, swz = sb ^ (((sb >> 9) & 1) << 5); R = (st >> 1) * 16 + swz / 64; C = (st & 1) * 32 + (swz % 64) / 2; }
__host__ __device__ __forceinline__ int perm32(int rho) { const int n = rho >> 4, i = rho & 15; return 8 * (i >> 2) + 4 * n + (i & 3); }

struct Unit { int pm, pn; };
struct Gemm { const bf16_t* A; const bf16_t* Bt; int M, N, K; };

struct StaticOrder {
    int nM, nN, nwg, G, c;
    __host__ __device__ void init(int M, int N, int G_, int c_) { nM = M / BM; nN = N / BM; nwg = nM * nN; G = G_; c = c_; }
    __host__ __device__ bool next(int i, Unit& u) const {
        const long L = (long)i * G + c; if (L >= nwg) return false;
        int wgid = (int)L; { const int q = nwg / NXCD, r = nwg % NXCD, xcd = wgid % NXCD, off = wgid / NXCD; wgid = (xcd < r ? xcd * (q + 1) : r * (q + 1) + (xcd - r) * q) + off; }
        const int nig = WGM * nN, gid = wgid / nig, fm = gid * WGM, gsz = (nM - fm) < WGM ? (nM - fm) : WGM;
        u.pm = fm + ((wgid % nig) % gsz); u.pn = (wgid % nig) / gsz; return true;
    }
    __device__ __forceinline__ void a_ready(const Unit&) const {}
    __device__ __forceinline__ void done(const Unit&) const {}
};

__device__ __forceinline__ unsigned cvt_pk_bf16(float lo, float hi) { unsigned r; asm volatile("v_cvt_pk_bf16_f32 %0, %1, %2" : "=v"(r) : "v"(lo), "v"(hi)); return r; }
typedef float f32x2 __attribute__((ext_vector_type(2)));
typedef unsigned u32x2 __attribute__((ext_vector_type(2)));
__device__ __forceinline__ float bf_lo(unsigned w) { return __uint_as_float(w << 16); }
__device__ __forceinline__ float bf_hi(unsigned w) { return __uint_as_float(w & 0xffff0000u); }
__device__ __forceinline__ float act_ug(float u, float g) {
    const float t = u * (u * u * (0.044715f * -2.302208198f) + -2.302208198f);
    const float e1 = __builtin_amdgcn_exp2f(t), e2 = __builtin_amdgcn_exp2f(g * -1.442695041f);
    return (u * g) * __builtin_amdgcn_rcpf((1.0f + e1) * (1.0f + e2));
}
__device__ __forceinline__ float act_gelu(float u) {
    const float t = u * (u * u * (0.044715f * -2.302208198f) + -2.302208198f);
    return u * __builtin_amdgcn_rcpf(1.0f + __builtin_amdgcn_exp2f(t));
}
__device__ __forceinline__ float act_silu(float g) { return g * __builtin_amdgcn_rcpf(1.0f + __builtin_amdgcn_exp2f(g * -1.442695041f)); }

struct EpiUG {
    static constexpr bool PERM = true, AFTER_DRAIN = false;
    bf16_t* P; const float* rs;
    __device__ __forceinline__ void operator()(const f32x4 (&acc)[2][2][4][2], const Unit& u, int wr, int wc, int fr, int fq) const {
        const int row0 = u.pm * BM + wr * 64 + fr, col0 = u.pn * 128 + wc * 32 + 8 * fq;
#pragma unroll
        for (int ai = 0; ai < 2; ++ai)
#pragma unroll
            for (int m = 0; m < 4; ++m) {
                const int r = row0 + ai * HALF + m * 16; const float s = rs[r];
                const f32x4 u0 = acc[ai][0][m][0] * s, u1 = acc[ai][0][m][1] * s, g0 = acc[ai][1][m][0] * s, g1 = acc[ai][1][m][1] * s;
                u32x4 w;
                w.x = cvt_pk_bf16(act_ug(u0[0], g0[0]), act_ug(u0[1], g0[1])); w.y = cvt_pk_bf16(act_ug(u0[2], g0[2]), act_ug(u0[3], g0[3]));
                w.z = cvt_pk_bf16(act_ug(u1[0], g1[0]), act_ug(u1[1], g1[1])); w.w = cvt_pk_bf16(act_ug(u1[2], g1[2]), act_ug(u1[3], g1[3]));
                *(u32x4*)(P + (size_t)r * 2048 + col0) = w;
            }
    }
};
struct EpiVT {
    static constexpr bool PERM = true, AFTER_DRAIN = false;
    bf16_t* VT; const float* rs; float* ST; int ntok;
    __device__ __forceinline__ void operator()(const f32x4 (&acc)[2][2][4][2], const Unit& u, int wr, int wc, int fr, int fq) const {
        const int vrow0 = u.pm * BM + wr * 64 + fr, tok0 = u.pn * BM + wc * 32 + 8 * fq;
        f32x4 rsv[2][2];
#pragma unroll
        for (int bj = 0; bj < 2; ++bj)
#pragma unroll
            for (int n = 0; n < 2; ++n) rsv[bj][n] = *(const f32x4*)(rs + tok0 + bj * HALF + 4 * n);
        float S[16], Q[16];
#pragma unroll
        for (int i = 0; i < 16; ++i) { S[i] = 0.f; Q[i] = 0.f; }
#pragma unroll
        for (int ai = 0; ai < 2; ++ai)
#pragma unroll
            for (int m = 0; m < 4; ++m) {
                bf16_t* rowp = VT + (size_t)(vrow0 + ai * HALF + m * 16) * ntok + tok0;
#pragma unroll
                for (int bj = 0; bj < 2; ++bj) {
                    float v[8];
#pragma unroll
                    for (int n = 0; n < 2; ++n)
#pragma unroll
                        for (int e = 0; e < 4; ++e) { const float x = act_gelu(acc[ai][bj][m][n][e] * rsv[bj][n][e]); v[n * 4 + e] = x; S[bj * 8 + n * 4 + e] += x; Q[bj * 8 + n * 4 + e] += x * x; }
                    u32x4 w; w.x = cvt_pk_bf16(v[0], v[1]); w.y = cvt_pk_bf16(v[2], v[3]); w.z = cvt_pk_bf16(v[4], v[5]); w.w = cvt_pk_bf16(v[6], v[7]);
                    *(u32x4*)(rowp + bj * HALF) = w;
                }
            }
#pragma unroll
        for (int k = 0; k < 4; ++k) {
            const bool hi = (fr >> k) & 1;
#pragma unroll
            for (int i = 0; i < (8 >> k); ++i) {
                const float s_lo = S[2 * i], s_hi = S[2 * i + 1], q_lo = Q[2 * i], q_hi = Q[2 * i + 1];
                const float s_send = hi ? s_lo : s_hi, q_send = hi ? q_lo : q_hi;
                const float s_keep = hi ? s_hi : s_lo, q_keep = hi ? q_hi : q_lo;
                S[i] = s_keep + __shfl_xor(s_send, 1 << k); Q[i] = q_keep + __shfl_xor(q_send, 1 << k);
            }
        }
        const int tok = u.pn * BM + (fr >> 3) * HALF + wc * 32 + 8 * fq + (fr & 7);
        *(f32x2*)(ST + ((size_t)(2 * u.pm + wr) * ntok + tok) * 2) = (f32x2){S[0], Q[0]};
    }
};
struct EpiRes1 {
    static constexpr bool PERM = true, AFTER_DRAIN = false;
    const float* X; float* X1; bf16_t* X1B; float* SS;
    __device__ __forceinline__ void operator()(const f32x4 (&acc)[2][2][4][2], const Unit& u, int wr, int wc, int fr, int fq) const {
        const int row0 = u.pm * BM + wr * 64 + fr, col0 = u.pn * BM + wc * 32 + 8 * fq;
#pragma unroll
        for (int ai = 0; ai < 2; ++ai)
#pragma unroll
            for (int m = 0; m < 4; ++m) {
                const int r = row0 + ai * HALF + m * 16; const size_t off = (size_t)r * 1024 + col0; float ss = 0.f;
#pragma unroll
                for (int bj = 0; bj < 2; ++bj) {
                    const f32x4 a0 = *(const f32x4*)(X + off + bj * HALF) + acc[ai][bj][m][0], a1 = *(const f32x4*)(X + off + bj * HALF + 4) + acc[ai][bj][m][1];
                    *(f32x4*)(X1 + off + bj * HALF) = a0; *(f32x4*)(X1 + off + bj * HALF + 4) = a1;
                    u32x4 w; w.x = cvt_pk_bf16(a0[0], a0[1]); w.y = cvt_pk_bf16(a0[2], a0[3]); w.z = cvt_pk_bf16(a1[0], a1[1]); w.w = cvt_pk_bf16(a1[2], a1[3]);
                    *(u32x4*)(X1B + off + bj * HALF) = w;
                    ss += (a0[0] * a0[0] + a0[1] * a0[1]) + (a0[2] * a0[2] + a0[3] * a0[3]) + (a1[0] * a1[0] + a1[1] * a1[1]) + (a1[2] * a1[2] + a1[3] * a1[3]);
                }
                ss += __shfl_xor(ss, 16); ss += __shfl_xor(ss, 32);
                if (fq == 0) SS[(size_t)r * 16 + 4 * u.pn + wc] = ss;
            }
    }
};
struct EpiXG {
    static constexpr bool PERM = true, AFTER_DRAIN = false;
    bf16_t* XB; bf16_t* SG; const float* SS;
    __device__ __forceinline__ void operator()(const f32x4 (&acc)[2][2][4][2], const Unit& u, int wr, int wc, int fr, int fq) const {
        const int row0 = u.pm * BM + wr * 64 + fr; const bool isg = u.pn >= 6;
        const int col0 = (isg ? u.pn - 6 : u.pn) * BM + wc * 32 + 8 * fq; bf16_t* O = isg ? SG : XB;
#pragma unroll
        for (int ai = 0; ai < 2; ++ai)
#pragma unroll
            for (int m = 0; m < 4; ++m) {
                const int r = row0 + ai * HALF + m * 16;
                const f32x4 pp = *(const f32x4*)(SS + (size_t)r * 16 + 4 * fq); float ss = (pp[0] + pp[1]) + (pp[2] + pp[3]);
                ss += __shfl_xor(ss, 16); ss += __shfl_xor(ss, 32);
                const float s = __builtin_amdgcn_rsqf(ss * (1.0f / 1024.0f) + 1e-6f);
#pragma unroll
                for (int bj = 0; bj < 2; ++bj) {
                    f32x4 v0 = acc[ai][bj][m][0] * s, v1 = acc[ai][bj][m][1] * s;
                    if (isg) {
#pragma unroll
                        for (int e = 0; e < 4; ++e) { v0[e] = act_silu(v0[e]); v1[e] = act_silu(v1[e]); } }
                    u32x4 w; w.x = cvt_pk_bf16(v0[0], v0[1]); w.y = cvt_pk_bf16(v0[2], v0[3]); w.z = cvt_pk_bf16(v1[0], v1[1]); w.w = cvt_pk_bf16(v1[2], v1[3]);
                    *(u32x4*)(O + (size_t)r * 1536 + col0 + bj * HALF) = w;
                }
            }
    }
};
struct EpiRes2 {
    static constexpr bool PERM = true, AFTER_DRAIN = false;
    const float* X1; float* X2;
    __device__ __forceinline__ void operator()(const f32x4 (&acc)[2][2][4][2], const Unit& u, int wr, int wc, int fr, int fq) const {
        const int row0 = u.pm * BM + wr * 64 + fr, col0 = u.pn * BM + wc * 32 + 8 * fq;
#pragma unroll
        for (int ai = 0; ai < 2; ++ai)
#pragma unroll
            for (int m = 0; m < 4; ++m) {
                const size_t off = (size_t)(row0 + ai * HALF + m * 16) * 1024 + col0;
#pragma unroll
                for (int bj = 0; bj < 2; ++bj) {
                    const f32x4 a0 = *(const f32x4*)(X1 + off + bj * HALF) + acc[ai][bj][m][0], a1 = *(const f32x4*)(X1 + off + bj * HALF + 4) + acc[ai][bj][m][1];
                    *(f32x4*)(X2 + off + bj * HALF) = a0; *(f32x4*)(X2 + off + bj * HALF + 4) = a1;
                }
            }
    }
};
template <class Epi, class Sched, bool ALIGN_EPI = false, bool SP2 = false>
__device__ __forceinline__ void gemm_phase(PG8_LAS unsigned char* lds, const Gemm g, const Sched& S, const Epi& E) {
    const int tid = threadIdx.x, wid = __builtin_amdgcn_readfirstlane(tid >> 6), lane = tid & 63, wr = wid >> 2, wc = wid & 3, fr = lane & 15, fq = lane >> 4;
    const int K = g.K, nt = K / BK;
    unsigned voffA[2], voffB[2];
#pragma unroll
    for (int i = 0; i < 2; ++i) { int R, C; stage_rc(tid * 16 + i * 8192, R, C); const int Rb = Epi::PERM ? ((R & ~31) + perm32(R & 31)) : R;
        voffA[i] = (unsigned)(R * K + C) * 2u; voffB[i] = (unsigned)(Rb * K + C) * 2u; }
    const size_t kstep = (size_t)(BK * 2);
    const size_t hstep = (size_t)HALF * K * 2;
    const size_t tstep = 2 * hstep;
    const unsigned ldsw = (unsigned)wid * 1024u;
    const int aoff = lds_byte(wr * 64 + fr, fq * 8), boff = lds_byte(wc * 32 + fr, fq * 8);
#define PG8_SA(b, h) (((b) * 2 + (h)) * HTB)
#define PG8_SB(b, h) ((4 + (b) * 2 + (h)) * HTB)
#define PG8_STAGE(bufoff, gbase, voff) do { _Pragma("unroll") for (int _i = 0; _i < 2; ++_i) \
        __builtin_amdgcn_global_load_lds((const unsigned*)((const char*)(gbase) + (voff)[_i]), (PG8_LAS unsigned*)(lds + (bufoff) + ldsw + _i * 8192), 16, 0, 0); } while (0)
#define PG8_LDA(dst, b, h) do { _Pragma("unroll") for (int m = 0; m < 4; ++m) _Pragma("unroll") for (int k = 0; k < 2; ++k) dst[m][k] = *(const PG8_LAS bf16x8*)(lds + PG8_SA(b, h) + aoff + m * 2048 + k * 1024); } while (0)
#define PG8_LDB(dst, b, h) do { _Pragma("unroll") for (int n = 0; n < 2; ++n) _Pragma("unroll") for (int k = 0; k < 2; ++k) dst[n][k] = *(const PG8_LAS bf16x8*)(lds + PG8_SB(b, h) + boff + n * 2048 + k * 1024); } while (0)
#define PG8_MMA(ai, bj, At, Bt) do { __builtin_amdgcn_s_setprio(1); _Pragma("unroll") for (int m = 0; m < 4; ++m) _Pragma("unroll") for (int n = 0; n < 2; ++n) _Pragma("unroll") for (int k = 0; k < 2; ++k) \
        acc[ai][bj][m][n] = __builtin_amdgcn_mfma_f32_16x16x32_bf16(Bt[n][k], At[m][k], acc[ai][bj][m][n], 0, 0, 0); __builtin_amdgcn_s_setprio(0); } while (0)
#define PG8_WAIT_V(n) asm volatile("s_waitcnt vmcnt(" #n ")" ::: "memory")
#define PG8_WAIT_L(n) asm volatile("s_waitcnt lgkmcnt(" #n ")" ::: "memory")
#define PG8_BAR __builtin_amdgcn_s_barrier()
#define PG8_SCHED __builtin_amdgcn_sched_barrier(0)
    Unit cur, nxt; int ui = 0;
    if (!S.next(0, cur)) return;
    f32x4 acc[2][2][4][2];
#pragma unroll
    for (int a = 0; a < 2; ++a)
#pragma unroll
        for (int b = 0; b < 2; ++b)
#pragma unroll
            for (int m = 0; m < 4; ++m)
#pragma unroll
                for (int n = 0; n < 2; ++n) acc[a][b][m][n] = (f32x4){0.f, 0.f, 0.f, 0.f};
    bf16x8 At[4][2], B0[2][2], B1[2][2];
    const char* cA = (const char*)g.A + (size_t)cur.pm * tstep; const char* cB = (const char*)g.Bt + (size_t)cur.pn * tstep;
    S.a_ready(cur);
    if constexpr (SP2) {
        PG8_STAGE(PG8_SB(0, 0), cB, voffB); PG8_STAGE(PG8_SB(0, 1), cB + hstep, voffB); PG8_STAGE(PG8_SA(0, 0), cA, voffA); PG8_STAGE(PG8_SA(0, 1), cA + hstep, voffA);
        if (wr == 1) PG8_BAR;
        PG8_WAIT_V(2); PG8_BAR;
        PG8_STAGE(PG8_SB(1, 0), cB + kstep, voffB); PG8_STAGE(PG8_SA(1, 0), cA + kstep, voffA); PG8_STAGE(PG8_SB(1, 1), cB + hstep + kstep, voffB);
        PG8_WAIT_V(6); PG8_BAR;
    } else {
        PG8_STAGE(PG8_SB(0, 0), cB, voffB); PG8_STAGE(PG8_SA(0, 0), cA, voffA); PG8_STAGE(PG8_SB(0, 1), cB + hstep, voffB); PG8_STAGE(PG8_SA(0, 1), cA + hstep, voffA);
        if (wr == 1) PG8_BAR;
        PG8_WAIT_V(4); PG8_BAR;
        PG8_STAGE(PG8_SB(1, 0), cB + kstep, voffB); PG8_STAGE(PG8_SA(1, 0), cA + kstep, voffA); PG8_STAGE(PG8_SB(1, 1), cB + hstep + kstep, voffB);
        PG8_WAIT_V(6); PG8_BAR;
    }
    for (;;) {
        const bool has_next = S.next(ui + 1, nxt);
        const char* nA = has_next ? (const char*)g.A + (size_t)nxt.pm * tstep : cA; const char* nB = has_next ? (const char*)g.Bt + (size_t)nxt.pn * tstep : cB;
        for (int t = 0; t < nt; t += 2) {
            const bool last = (t == nt - 2);
            const char* a1 = cA + (size_t)(t + 1) * kstep;
            const char* a2 = last ? nA : cA + (size_t)(t + 2) * kstep; const char* b2 = last ? nB : cB + (size_t)(t + 2) * kstep;
            const char* a3 = a2 + kstep; const char* b3 = b2 + kstep;
            if (last && has_next) S.a_ready(nxt);
            if constexpr (SP2) {
            PG8_LDB(B0, 0, 0); PG8_LDB(B1, 0, 1); PG8_SCHED; PG8_LDA(At, 0, 0); PG8_STAGE(PG8_SA(1, 1), a1 + hstep, voffA);
            PG8_WAIT_V(8); PG8_WAIT_L(0); PG8_BAR; PG8_MMA(0, 0, At, B0); PG8_MMA(0, 1, At, B1); PG8_BAR; PG8_SCHED;
            PG8_LDA(At, 0, 1); PG8_STAGE(PG8_SB(0, 0), b2, voffB); PG8_STAGE(PG8_SB(0, 1), b2 + hstep, voffB); PG8_STAGE(PG8_SA(0, 0), a2, voffA);
            PG8_WAIT_V(8); PG8_WAIT_L(0); PG8_BAR; PG8_MMA(1, 0, At, B0); PG8_MMA(1, 1, At, B1); PG8_BAR; PG8_SCHED;
            PG8_LDB(B0, 1, 0); PG8_LDB(B1, 1, 1); PG8_SCHED; PG8_LDA(At, 1, 0); PG8_STAGE(PG8_SA(0, 1), a2 + hstep, voffA);
            PG8_WAIT_V(8); PG8_WAIT_L(0); PG8_BAR; PG8_MMA(0, 0, At, B0); PG8_MMA(0, 1, At, B1); PG8_BAR; PG8_SCHED;
            PG8_LDA(At, 1, 1); PG8_STAGE(PG8_SB(1, 0), b3, voffB); PG8_STAGE(PG8_SB(1, 1), b3 + hstep, voffB); PG8_STAGE(PG8_SA(1, 0), a3, voffA);
            PG8_WAIT_V(8); PG8_WAIT_L(0); PG8_BAR; PG8_MMA(1, 0, At, B0); PG8_MMA(1, 1, At, B1); PG8_BAR; PG8_SCHED;
            } else {
            PG8_LDB(B0, 0, 0); PG8_SCHED; PG8_LDA(At, 0, 0); PG8_STAGE(PG8_SA(1, 1), a1 + hstep, voffA);
            PG8_WAIT_L(8); PG8_BAR; PG8_WAIT_L(0); PG8_MMA(0, 0, At, B0); PG8_BAR; PG8_SCHED;
            PG8_LDB(B1, 0, 1); PG8_STAGE(PG8_SB(0, 0), b2, voffB);
            PG8_BAR; PG8_WAIT_L(0); PG8_MMA(0, 1, At, B1); PG8_BAR;
            PG8_LDA(At, 0, 1); PG8_STAGE(PG8_SA(0, 0), a2, voffA);
            PG8_BAR; PG8_WAIT_L(0); PG8_MMA(1, 0, At, B0); PG8_BAR; PG8_SCHED;
            PG8_STAGE(PG8_SB(0, 1), b2 + hstep, voffB);
            PG8_WAIT_V(6); PG8_BAR; PG8_MMA(1, 1, At, B1); PG8_BAR;
            PG8_LDB(B0, 1, 0); PG8_SCHED; PG8_LDA(At, 1, 0); PG8_STAGE(PG8_SA(0, 1), a2 + hstep, voffA);
            PG8_WAIT_L(8); PG8_BAR; PG8_WAIT_L(0); PG8_MMA(0, 0, At, B0); PG8_BAR; PG8_SCHED;
            PG8_LDB(B1, 1, 1); PG8_STAGE(PG8_SB(1, 0), b3, voffB);
            PG8_BAR; PG8_WAIT_L(0); PG8_MMA(0, 1, At, B1); PG8_BAR;
            PG8_LDA(At, 1, 1); PG8_STAGE(PG8_SA(1, 0), a3, voffA);
            PG8_BAR; PG8_WAIT_L(0); PG8_MMA(1, 0, At, B0); PG8_BAR; PG8_SCHED;
            PG8_STAGE(PG8_SB(1, 1), b3 + hstep, voffB);
            PG8_WAIT_V(6); PG8_BAR; PG8_MMA(1, 1, At, B1); PG8_BAR;
            }
        }
        if constexpr (ALIGN_EPI) { if (wr == 0) PG8_BAR; }
        if constexpr (!Epi::AFTER_DRAIN) { E(acc, cur, wr, wc, fr, fq); S.done(cur); }
        if (!has_next) break;
#pragma unroll
        for (int a = 0; a < 2; ++a)
#pragma unroll
            for (int b = 0; b < 2; ++b)
#pragma unroll
                for (int m = 0; m < 4; ++m)
#pragma unroll
                    for (int n = 0; n < 2; ++n) acc[a][b][m][n] = (f32x4){0.f, 0.f, 0.f, 0.f};
        cur = nxt; cA = nA; cB = nB; ++ui;
        if constexpr (ALIGN_EPI) { if (wr == 1) PG8_BAR; }
    }
    PG8_WAIT_V(0);
    if constexpr (!ALIGN_EPI) { if (wr == 0) PG8_BAR; }
    PG8_BAR;
    if constexpr (Epi::AFTER_DRAIN) { E.fused(acc, cur, wr, wc, fr, fq, lds, wid, lane); S.done(cur); }
#undef PG8_SA
#undef PG8_SB
#undef PG8_STAGE
#undef PG8_LDA
#undef PG8_LDB
#undef PG8_MMA
#undef PG8_WAIT_V
#undef PG8_WAIT_L
#undef PG8_BAR
#undef PG8_SCHED
}
}
#ifndef PG8_SP2
#define PG8_SP2 true
#endif
#ifndef PG8_ALIGN
#define PG8_ALIGN true
#endif
#define GAS __attribute__((address_space(1)))
#define LAS __attribute__((address_space(3)))
typedef unsigned short bf16;
typedef unsigned v4u __attribute__((ext_vector_type(4)));
typedef float f32x4 __attribute__((ext_vector_type(4)));
typedef short bf16x8 __attribute__((ext_vector_type(8)));
typedef GAS unsigned gu32;
typedef GAS unsigned long long gu64;
#define RLX_AGENT __ATOMIC_RELAXED, __HIP_MEMORY_SCOPE_AGENT
#define LDS_WAIT() asm volatile("s_waitcnt lgkmcnt(0)" ::: "memory")
#define VM_WAIT() asm volatile("s_waitcnt vmcnt(0)" ::: "memory")
__device__ __forceinline__ unsigned long long rt() { return __builtin_amdgcn_s_memrealtime(); }
__device__ __forceinline__ unsigned f2bf(float f) { unsigned u = __builtin_bit_cast(unsigned, f); return (u + 0x7fffu + ((u >> 16) & 1u)) >> 16; }
__device__ __forceinline__ unsigned pk2(float lo, float hi) { return f2bf(lo) | (f2bf(hi) << 16); }

#define XB_TMO      128
#define XB_XCNT(j)  (256  + 64 * (j))
#define XB_XSUB(j)  (1280 + 64 * (j))
#define XB_XGEN(j)  (2304 + 64 * (j))
#define XB_TOP      3328
#define XB_TOPGEN   3392
#define XCD_BAR_WORDS 3456
#define XB_SPIN_CAP (1u << 18)

__device__ __forceinline__ unsigned xb_ld(unsigned* p)              { return __hip_atomic_load(p, __ATOMIC_RELAXED, __HIP_MEMORY_SCOPE_AGENT); }
__device__ __forceinline__ unsigned xb_add(unsigned* p, unsigned v) { return __hip_atomic_fetch_add(p, v, __ATOMIC_RELAXED, __HIP_MEMORY_SCOPE_AGENT); }
__device__ __forceinline__ unsigned xb_xcc_id() { return (unsigned)__builtin_amdgcn_s_getreg((3 << 11) | 20) & 0xFu; }
#define XB_SPIN(cond, bar) do { unsigned _sp = 0; while (cond) { __builtin_amdgcn_s_sleep(1); \
    if ((++_sp & 255u) == 0u) { if (xb_ld(&(bar)[XB_TMO])) break; if (_sp > XB_SPIN_CAP) { atomicAdd(&(bar)[XB_TMO], 1u); break; } } } } while (0)

struct XcdBarrier {
    unsigned* bar; unsigned x;
    volatile LAS unsigned* st;
};

__device__ __forceinline__ XcdBarrier xcd_barrier_post(unsigned* bar, volatile LAS unsigned* st) {
    XcdBarrier b; b.bar = bar; b.x = xb_xcc_id(); b.st = st;
    if (threadIdx.x == 0) (void)xb_add(&bar[XB_XCNT(b.x)], 1u);
    return b;
}
__device__ __forceinline__ void xcd_barrier_complete(unsigned* bar, unsigned x, unsigned& nloc, unsigned& nx) {
    const unsigned G = gridDim.x * gridDim.y * gridDim.z;
    unsigned sum, cnt, mine, sp = 0u;
    for (;;) {
        sum = 0u; cnt = 0u; mine = 0u;
#pragma unroll
        for (unsigned j = 0; j < 16; ++j) { const unsigned c = xb_ld(&bar[XB_XCNT(j)]); sum += c; cnt += (c > 0u) ? 1u : 0u; mine = (j == x) ? c : mine; }
        if (sum == G) break;
        __builtin_amdgcn_s_sleep(1);
        if ((++sp & 255u) == 0u) { if (xb_ld(&bar[XB_TMO])) break; if (sp > XB_SPIN_CAP) { atomicAdd(&bar[XB_TMO], 1u); break; } }
    }
    nloc = mine > 0u ? mine : 1u; nx = cnt > 0u ? cnt : 1u;
}

__device__ __forceinline__ void xcd_barrier(const XcdBarrier& b) {
    asm volatile("s_waitcnt vmcnt(0)" ::: "memory");
    __syncthreads();
    if (threadIdx.x == 0) {
        unsigned* bar = b.bar;
        __builtin_amdgcn_s_waitcnt(0);
        unsigned nloc = b.st[0], nx = b.st[1];
        if (nloc == 0u) { xcd_barrier_complete(bar, b.x, nloc, nx); b.st[0] = nloc; b.st[1] = nx; }
        const unsigned old = xb_add(&bar[XB_XSUB(b.x)], 1u);
        const unsigned gen = old / nloc;
        if (old + 1u == (gen + 1u) * nloc) {
            __builtin_amdgcn_fence(__ATOMIC_RELEASE, "agent");
            asm volatile("s_waitcnt vmcnt(0)" ::: "memory");
            const unsigned og = xb_add(&bar[XB_TOP], 1u);
            const unsigned tg = og / nx;
            if (og + 1u == (tg + 1u) * nx) xb_add(&bar[XB_TOPGEN], 1u);
            else XB_SPIN(xb_ld(&bar[XB_TOPGEN]) == tg, bar);
            __builtin_amdgcn_fence(__ATOMIC_ACQUIRE, "agent");
            xb_add(&bar[XB_XGEN(b.x)], 1u);
            asm volatile("s_waitcnt vmcnt(0)" ::: "memory");
        } else {
            XB_SPIN(xb_ld(&bar[XB_XGEN(b.x)]) == gen, bar);
            __builtin_amdgcn_fence(__ATOMIC_ACQUIRE, "agent");
            asm volatile("s_waitcnt vmcnt(0)" ::: "memory");
        }
    }
    __syncthreads();
}

constexpr int NWAVES = 8;
constexpr int DM = 1024, NBATCH = 8, SEQ = 2048, M = NBATCH * SEQ;
constexpr int AW = 2048, AG = 8, AGD = 256, CH = 128;
constexpr int BW = 1536, BH = 12, BD = 128;
constexpr size_t MiB = 1u << 20;
constexpr size_t WS_CTL = 0, CTL_ZERO_BYTES = 1 * MiB;
constexpr size_t WS_W1UG = 1 * MiB, WS_W1V = 9 * MiB, WS_W2 = 13 * MiB, WS_W3 = 17 * MiB, WS_W4 = 23 * MiB, WS_WG = 26 * MiB;
constexpr size_t WS_RS0 = 26 * MiB + 768 * 1024, WS_SS1 = 27 * MiB, WS_ST = 28 * MiB, WS_AGG = 30 * MiB;
constexpr size_t AGG_BYTES = (size_t)16 * 96 * 128 * 8;
constexpr size_t WS_XB16 = 32 * MiB;
constexpr size_t WS_P = 64 * MiB;
constexpr size_t WS_VT = 128 * MiB;
constexpr size_t WS_SCR = 192 * MiB, WS_END = 256 * MiB;
#ifndef MK_REPEAT
#define MK_REPEAT -1
#endif
#ifndef P5_PROBE
#define P5_PROBE 0
#endif
constexpr int CW_BAR = 4096;
constexpr int RING_OFF = 0, RING_BYTES = 131072;
constexpr int LDSCTL_OFF = RING_BYTES, MISC_OFF = LDSCTL_OFF + 320;
constexpr int LDS_BYTES = 147456;

struct Frame {
    LAS unsigned char* lds;
    volatile LAS unsigned* MISC;
    gu32* ctl;
    int tid, lane, wave;
    int vcu, G;
    const float *x, *norm_w, *a_w_in, *a_ln_w, *a_ln_b, *a_w_s, *a_b_s, *a_w_out, *b_w_in, *b_conv_w, *b_conv_b, *b_gate_a_w, *b_gate_a_b, *b_gate_x_w, *b_gate_x_b, *b_lambda, *b_w_out, *norm_f_w;
    float* out;
    bf16 *W1UG, *W1V, *W2, *W3, *W4, *WGT;
    float *RS0, *SS1, *ST; unsigned long long* AGG;
    bf16 *XB16, *P, *VT, *XBC, *SG;
};

__device__ __forceinline__ float wave_sum(float v) {
#pragma unroll
    for (int o = 1; o < 64; o <<= 1) v += __shfl_xor(v, o);
    return v;
}
__device__ __forceinline__ float bf2f(unsigned short b) { return __uint_as_float(((unsigned)b) << 16); }
__device__ __forceinline__ void p0_tr(const float* W, int ldw, int col0, int k0, const float* ks, bf16* WT, int Kd, LAS float* scr, int lane) {
#pragma unroll 8
    for (int i = 0; i < 32; ++i) { const int kk = 2 * i + (lane >> 5); float v = W[(size_t)(k0 + kk) * ldw + col0 + (lane & 31)]; if (ks) v *= ks[k0 + kk]; scr[kk * 33 + (lane & 31)] = v; }
    LDS_WAIT(); asm volatile("" ::: "memory");
    const int c = lane & 7;
#pragma unroll
    for (int j = 0; j < 4; ++j) { const int n = (lane >> 3) + 8 * j; const LAS float* s = scr + (8 * c) * 33 + n;
        v4u o; o.x = pk2(s[0 * 33], s[1 * 33]); o.y = pk2(s[2 * 33], s[3 * 33]); o.z = pk2(s[4 * 33], s[5 * 33]); o.w = pk2(s[6 * 33], s[7 * 33]);
        *(GAS v4u*)(WT + (size_t)n * Kd + k0 + 8 * c) = o; }
    LDS_WAIT(); asm volatile("" ::: "memory");
}
__device__ __forceinline__ void p0_prologue(Frame& F) {
    LAS float* scr = (LAS float*)(F.lds + RING_OFF + F.wave * 16384);
    const int gw = F.vcu * NWAVES + F.wave, NGW = F.G * NWAVES;
    constexpr int I_W1 = 16 * 192, I_W2 = 32 * 32, I_W3 = 16 * 96, I_W4 = 24 * 32, I_G = 24 * 8;
    constexpr int NITEMS = I_W1 + I_W2 + I_W3 + I_W4 + I_G;
    for (int it = gw; it < NITEMS; it += NGW) {
        int r = it;
        if (r < I_W1) { const int kb = r / 192, nb = r % 192; bf16* dst;
            if (nb < 64) dst = F.W1UG + (size_t)(256 * (nb >> 2) + 32 * (nb & 3)) * DM;
            else if (nb < 128) dst = F.W1V + (size_t)(32 * (nb - 64)) * DM;
            else { const int q = nb - 128; dst = F.W1UG + (size_t)(256 * (q >> 2) + 128 + 32 * (q & 3)) * DM; }
            p0_tr(F.a_w_in, 3 * AW, 32 * nb, 64 * kb, F.norm_w, dst, DM, scr, F.lane); continue; } r -= I_W1;
        if (r < I_W2) { const int kb = r / 32, nb = r % 32; p0_tr(F.a_w_out, DM, 32 * nb, 64 * kb, nullptr, F.W2 + (size_t)(32 * nb) * AW, AW, scr, F.lane); continue; } r -= I_W2;
        if (r < I_W3) { const int kb = r / 96, nb = r % 96; p0_tr(F.b_w_in, 2 * BW, 32 * nb, 64 * kb, F.norm_w + DM, F.W3 + (size_t)(32 * nb) * DM, DM, scr, F.lane); continue; } r -= I_W3;
        if (r < I_W4) { const int kb = r / 32, nb = r % 32; p0_tr(F.b_w_out, DM, 32 * nb, 64 * kb, nullptr, F.W4 + (size_t)(32 * nb) * BW, BW, scr, F.lane); continue; } r -= I_W4;
        { const int mat = r / 8, kb = (r % 8) / 4, nb = r % 4;
          const float* src = (mat < 12 ? F.b_gate_a_w : F.b_gate_x_w) + (size_t)(mat % 12) * BD * BD;
          p0_tr(src, BD, 32 * nb, 64 * kb, nullptr, F.WGT + (size_t)mat * BD * BD + (size_t)(32 * nb) * BD, BD, scr, F.lane); }
    }
    for (int m = gw; m < M; m += NGW) {
        const GAS f32x4* xr = (const GAS f32x4*)(F.x + (size_t)m * DM) + F.lane;
        f32x4 v[4]; float s = 0.f;
#pragma unroll
        for (int j = 0; j < 4; ++j) { v[j] = xr[64 * j]; s += (v[j].x * v[j].x + v[j].y * v[j].y) + (v[j].z * v[j].z + v[j].w * v[j].w); }
        s = wave_sum(s);
        if (F.lane == 0) F.RS0[m] = 1.0f / sqrtf(s * (1.0f / DM) + 1e-6f);
        GAS unsigned long long* o8 = (GAS unsigned long long*)(F.XB16 + (size_t)m * DM) + F.lane;
#pragma unroll
        for (int j = 0; j < 4; ++j) o8[64 * j] = (unsigned long long)pk2(v[j].x, v[j].y) | ((unsigned long long)pk2(v[j].z, v[j].w) << 32);
    }
    { GAS v4u* z = (GAS v4u*)F.AGG; for (int i = gw * 64 + F.lane; i < (int)(AGG_BYTES / 16); i += NGW * 64) z[i] = (v4u){0u, 0u, 0u, 0u}; }
}

__device__ __forceinline__ void sgu_unit(Frame& F, int chunk, int g, bf16* Yout) {
    const int tid = F.tid, lane = F.lane, w = F.wave, fr = lane & 15, fq = lane >> 4;
    LAS unsigned char* img = F.lds + RING_OFF;
    LAS float* tab = (LAS float*)(F.lds + RING_OFF + 32768);
    bf16x8 Af[2][4];
    { const bf16* vt = F.VT + (size_t)(g * AGD + 32 * w + fr) * M + chunk * CH + 8 * fq;
#pragma unroll
      for (int mi = 0; mi < 2; ++mi)
#pragma unroll
          for (int kk = 0; kk < 4; ++kk) Af[mi][kk] = *(const GAS bf16x8*)(vt + (size_t)(16 * mi) * M + 32 * kk); }
    if (tid < CH) {
        const int token = chunk * CH + tid; float S = 0.f, Q = 0.f;
#pragma unroll
        for (int sl = 0; sl < 16; ++sl) { const pg8::f32x2 pq = *(const GAS pg8::f32x2*)(F.ST + ((size_t)sl * M + token) * 2); S += pq.x; Q += pq.y; }
        const float mean = S * (1.0f / AW), var = Q * (1.0f / AW) - mean * mean;
        tab[tid] = mean; tab[128 + tid] = 1.0f / sqrtf(var + 1e-5f); tab[512 + tid] = F.a_b_s[g * CH + tid];
    }
    __syncthreads();
    { const int t = tid >> 2, sq = tid & 3; const float* wrow = F.a_w_s + ((size_t)g * CH + t) * CH + 32 * sq; float c1 = 0.f, c2 = 0.f;
#pragma unroll
      for (int q = 0; q < 4; ++q) { const int s0 = 32 * sq + 8 * q;
          const f32x4 w0 = *(const GAS f32x4*)(wrow + 8 * q), w1 = *(const GAS f32x4*)(wrow + 8 * q + 4);
          const float wv[8] = {w0.x, w0.y, w0.z, w0.w, w1.x, w1.y, w1.z, w1.w}; unsigned bits[8];
#pragma unroll
          for (int j = 0; j < 8; ++j) { const float wm = (s0 + j <= t) ? wv[j] : 0.f; c2 += wm; bits[j] = f2bf(wm * tab[128 + s0 + j]); c1 += tab[s0 + j] * __uint_as_float(bits[j] << 16); }
          v4u o; o.x = bits[0] | (bits[1] << 16); o.y = bits[2] | (bits[3] << 16); o.z = bits[4] | (bits[5] << 16); o.w = bits[6] | (bits[7] << 16);
          *(LAS v4u*)(img + t * 256 + (((4 * sq + q) ^ (t & 15)) * 16)) = o; }
      c1 += __shfl_xor(c1, 1); c1 += __shfl_xor(c1, 2); c2 += __shfl_xor(c2, 1); c2 += __shfl_xor(c2, 2);
      if (sq == 0) { tab[256 + t] = c1; tab[384 + t] = c2; } }
    __syncthreads();
    f32x4 acc[2][8];
#pragma unroll
    for (int mi = 0; mi < 2; ++mi)
#pragma unroll
        for (int nj = 0; nj < 8; ++nj) acc[mi][nj] = (f32x4){0.f, 0.f, 0.f, 0.f};
#pragma unroll
    for (int nj = 0; nj < 8; ++nj)
#pragma unroll
        for (int kk = 0; kk <= nj / 2; ++kk) {
            const bf16x8 Bf = *(const LAS bf16x8*)(img + (16 * nj + fr) * 256 + (((4 * kk + fq) ^ fr) * 16));
#pragma unroll
            for (int mi = 0; mi < 2; ++mi) acc[mi][nj] = __builtin_amdgcn_mfma_f32_16x16x32_bf16(Af[mi][kk], Bf, acc[mi][nj], 0, 0, 0);
        }
#pragma unroll
    for (int mi = 0; mi < 2; ++mi) {
        const int col0 = g * AGD + 32 * w + 16 * mi + 4 * fq;
        const f32x4 lw = *(const GAS f32x4*)(F.a_ln_w + col0), lb = *(const GAS f32x4*)(F.a_ln_b + col0);
#pragma unroll
        for (int nj = 0; nj < 8; ++nj) {
            const int tl = 16 * nj + fr; const float c1t = tab[256 + tl], c2t = tab[384 + tl], bst = tab[512 + tl];
            GAS pg8::u32x2* pp = (GAS pg8::u32x2*)(F.P + (size_t)(chunk * CH + tl) * AW + col0);
            const pg8::u32x2 pv = *pp;
            const float p0 = pg8::bf_lo(pv.x), p1 = pg8::bf_hi(pv.x), p2 = pg8::bf_lo(pv.y), p3 = pg8::bf_hi(pv.y);
            const f32x4 a = acc[mi][nj];
            const float y0 = p0 * (lw.x * (a.x - c1t) + lb.x * c2t + bst), y1 = p1 * (lw.y * (a.y - c1t) + lb.y * c2t + bst);
            const float y2 = p2 * (lw.z * (a.z - c1t) + lb.z * c2t + bst), y3 = p3 * (lw.w * (a.w - c1t) + lb.w * c2t + bst);
            pg8::u32x2 o; o.x = pk2(y0, y1); o.y = pk2(y2, y3); *(GAS pg8::u32x2*)(Yout + (size_t)(chunk * CH + tl) * AW + col0) = o;
        }
    }
    __syncthreads();
}

#define P5_LB 2
constexpr int P5_UNITS = (SEQ / CH) * NBATCH * BH;
constexpr int P5_TAB = 32768;
template <int CTRL> __device__ __forceinline__ float dpp_f(float old, float src) {
    return __builtin_bit_cast(float, __builtin_amdgcn_update_dpp(__builtin_bit_cast(int, old), __builtin_bit_cast(int, src), CTRL, 0xf, 0xf, false)); }
#define P5_SCAN_STEP(D) asm volatile("s_nop 1\n\t" \
    "v_fmac_f32_dpp %4, %4, %0 row_shr:" #D " row_mask:0xf bank_mask:0xf\n\tv_fmac_f32_dpp %5, %5, %1 row_shr:" #D " row_mask:0xf bank_mask:0xf\n\t" \
    "v_fmac_f32_dpp %6, %6, %2 row_shr:" #D " row_mask:0xf bank_mask:0xf\n\tv_fmac_f32_dpp %7, %7, %3 row_shr:" #D " row_mask:0xf bank_mask:0xf\n\t" \
    "v_mul_f32_dpp %0, %0, %0 row_shr:" #D " row_mask:0xf bank_mask:0xf\n\tv_mul_f32_dpp %1, %1, %1 row_shr:" #D " row_mask:0xf bank_mask:0xf\n\t" \
    "v_mul_f32_dpp %2, %2, %2 row_shr:" #D " row_mask:0xf bank_mask:0xf\n\tv_mul_f32_dpp %3, %3, %3 row_shr:" #D " row_mask:0xf bank_mask:0xf\n\ts_nop 1" \
    : "+v"(av[0]), "+v"(av[1]), "+v"(av[2]), "+v"(av[3]), "+v"(bv[0]), "+v"(bv[1]), "+v"(bv[2]), "+v"(bv[3]))

__device__ __forceinline__ void rglru_phase(Frame& F, bf16* Yout) {
    const int tid = F.tid, lane = F.lane, w = F.wave, fr = lane & 15, fq = lane >> 4;
    LAS unsigned char* img = F.lds + RING_OFF;
    LAS float* tab = (LAS float*)(F.lds + RING_OFF + P5_TAB);
    for (int c = tid; c < BW; c += NWAVES * 64) {
#pragma unroll
        for (int k = 0; k < 4; ++k) tab[k * BW + c] = F.b_conv_w[k * BW + c];
        tab[4 * BW + c] = F.b_conv_b[c]; tab[5 * BW + c] = F.b_gate_a_b[c]; tab[6 * BW + c] = F.b_gate_x_b[c];
        const float nl = -F.b_lambda[c]; const float sp = fmaxf(nl, 0.f) + log1pf(expf(-fabsf(nl))); tab[7 * BW + c] = -8.0f * 1.442695041f * sp;
    }
    const int cv = tid & 15, tg = tid >> 4;
    v4u xr[7]; bf16x8 WA[4], WX[4];
#define P5_LOAD_UNIT(uu) do { const int u_ = (uu) < P5_UNITS ? (uu) : P5_UNITS - 1; const int j_ = u_ / (NBATCH * BH), bh_ = u_ % (NBATCH * BH), b_ = bh_ / BH, h_ = bh_ % BH; \
        _Pragma("unroll") for (int i = 0; i < 7; ++i) { const int t = j_ * CH + 4 * tg - 3 + i; const int tc = t < 0 ? 0 : t; \
            xr[i] = *(const GAS v4u*)(F.XBC + (size_t)(b_ * SEQ + tc) * BW + h_ * BD + 8 * cv); } \
        const bf16* wa = F.WGT + ((size_t)h_ * BD + 16 * w + fr) * BD + 8 * fq; const bf16* wx = F.WGT + ((size_t)(BH + h_) * BD + 16 * w + fr) * BD + 8 * fq; \
        _Pragma("unroll") for (int kk = 0; kk < 4; ++kk) { WA[kk] = *(const GAS bf16x8*)(wa + 32 * kk); WX[kk] = *(const GAS bf16x8*)(wx + 32 * kk); } } while (0)
    P5_LOAD_UNIT(F.vcu);
    __syncthreads();
    for (int u = F.vcu; u < P5_UNITS; u += F.G) {
        const int j = u / (NBATCH * BH), bh = u % (NBATCH * BH), b = bh / BH, h = bh % BH;
        const int t0 = j * CH, chc = h * BD + 8 * cv, chl = h * BD + 16 * w + 4 * fq;
        {
            float cw[4][8], cb[8];
#pragma unroll
            for (int k = 0; k < 4; ++k) { const f32x4 a0 = *(const LAS f32x4*)(tab + k * BW + chc), a1 = *(const LAS f32x4*)(tab + k * BW + chc + 4);
                cw[k][0] = a0.x; cw[k][1] = a0.y; cw[k][2] = a0.z; cw[k][3] = a0.w; cw[k][4] = a1.x; cw[k][5] = a1.y; cw[k][6] = a1.z; cw[k][7] = a1.w; }
            { const f32x4 a0 = *(const LAS f32x4*)(tab + 4 * BW + chc), a1 = *(const LAS f32x4*)(tab + 4 * BW + chc + 4);
              cb[0] = a0.x; cb[1] = a0.y; cb[2] = a0.z; cb[3] = a0.w; cb[4] = a1.x; cb[5] = a1.y; cb[6] = a1.z; cb[7] = a1.w; }
#pragma unroll
            for (int i = 0; i < 7; ++i) { const unsigned keep = (t0 + 4 * tg - 3 + i) < 0 ? 0u : 0xffffffffu; xr[i].x &= keep; xr[i].y &= keep; xr[i].z &= keep; xr[i].w &= keep; }
#pragma unroll
            for (int i = 0; i < 4; ++i) { float o[8];
#pragma unroll
                for (int c = 0; c < 8; ++c) o[c] = cb[c];
#pragma unroll
                for (int k = 0; k < 4; ++k) { const v4u q = xr[i + k]; const unsigned qq[4] = {q.x, q.y, q.z, q.w};
#pragma unroll
                    for (int c2 = 0; c2 < 4; ++c2) { o[2 * c2] = fmaf(cw[k][2 * c2], pg8::bf_lo(qq[c2]), o[2 * c2]); o[2 * c2 + 1] = fmaf(cw[k][2 * c2 + 1], pg8::bf_hi(qq[c2]), o[2 * c2 + 1]); } }
                v4u pk; pk.x = pk2(o[0], o[1]); pk.y = pk2(o[2], o[3]); pk.z = pk2(o[4], o[5]); pk.w = pk2(o[6], o[7]);
                const int row = 4 * tg + i; *(LAS v4u*)(img + row * 256 + ((cv ^ (row & 15)) * 16)) = pk; }
        }
        const f32x4 ba = *(const LAS f32x4*)(tab + 5 * BW + chl), bx = *(const LAS f32x4*)(tab + 6 * BW + chl), nsp = *(const LAS f32x4*)(tab + 7 * BW + chl);
        __syncthreads();
        pg8::u32x2 sgq[8];
#pragma unroll
        for (int nb = 0; nb < 8; ++nb) sgq[nb] = *(const GAS pg8::u32x2*)(F.SG + (size_t)(b * SEQ + t0 + 16 * nb + fr) * BW + chl);
        float Ac[8][4], Hl[8][4];
#pragma unroll
        for (int nb = 0; nb < 8; ++nb) {
            const int row = 16 * nb + fr;
            f32x4 aA = {0.f, 0.f, 0.f, 0.f}, aX = {0.f, 0.f, 0.f, 0.f};
#pragma unroll
            for (int kk = 0; kk < 4; ++kk) { const bf16x8 Bf = *(const LAS bf16x8*)(img + row * 256 + (((4 * kk + fq) ^ fr) * 16));
                aA = __builtin_amdgcn_mfma_f32_16x16x32_bf16(WA[kk], Bf, aA, 0, 0, 0); aX = __builtin_amdgcn_mfma_f32_16x16x32_bf16(WX[kk], Bf, aX, 0, 0, 0); }
            const pg8::u32x2 xq = *(const LAS pg8::u32x2*)(img + row * 256 + (((2 * w + (fq >> 1)) ^ fr) * 16) + 8 * (fq & 1));
            const float xcv[4] = {pg8::bf_lo(xq.x), pg8::bf_hi(xq.x), pg8::bf_lo(xq.y), pg8::bf_hi(xq.y)};
            float av[4], bv[4];
#pragma unroll
            for (int e = 0; e < 4; ++e) {
                const float rg = __builtin_amdgcn_rcpf(1.0f + __builtin_amdgcn_exp2f((aA[e] + ba[e]) * -1.442695041f));
                const float ig = __builtin_amdgcn_rcpf(1.0f + __builtin_amdgcn_exp2f((aX[e] + bx[e]) * -1.442695041f));
                const float a = __builtin_amdgcn_exp2f(rg * nsp[e]);
                av[e] = a; bv[e] = __builtin_amdgcn_sqrtf(fmaxf(1.0f - a * a, 0.f)) * (ig * xcv[e]);
            }
            if (nb > 0) {
#pragma unroll
                for (int e = 0; e < 4; ++e) { const float cA = dpp_f<0x121>(1.0f, Ac[nb - 1][e]), cH = dpp_f<0x121>(0.0f, Hl[nb - 1][e]);
                    if (fr == 0) { bv[e] = fmaf(av[e], cH, bv[e]); av[e] = av[e] * cA; } }
            }
            P5_SCAN_STEP(1); P5_SCAN_STEP(2); P5_SCAN_STEP(4); P5_SCAN_STEP(8);
#pragma unroll
            for (int e = 0; e < 4; ++e) { Hl[nb][e] = bv[e]; Ac[nb][e] = av[e]; }
        }
        if (fr == 15) { gu64* ga = (gu64*)F.AGG + ((size_t)u * BD + 16 * w + 4 * fq);
#pragma unroll
            for (int e = 0; e < 4; ++e) __hip_atomic_store(ga + e, ((unsigned long long)__float_as_uint(Hl[7][e]) << 32) | (unsigned long long)(__float_as_uint(Ac[7][e]) | 1u), RLX_AGENT); }
        P5_LOAD_UNIT(u + F.G);
        float hin[4];
        {
            const int jj = lane >> 2, q = lane & 3; const bool need = jj < j;
            const gu64* gp = (const gu64*)F.AGG + ((size_t)(jj * (NBATCH * BH) + bh) * BD + 16 * w + 4 * q);
            unsigned long long gr[4];
#pragma unroll
            for (int k = 0; k < 4; ++k) gr[k] = 0ull;
            unsigned spins = 0;
            for (;;) {
                bool ok = true;
                if (need) {
#pragma unroll
                    for (int k = 0; k < 4; ++k) { gr[k] = __hip_atomic_load(gp + k, RLX_AGENT); ok = ok && ((unsigned)gr[k] != 0u); } }
                if (__all(ok)) break;
                __builtin_amdgcn_s_sleep(2);
                if (++spins > (1u << 22)) { if (lane == 0) __hip_atomic_store(F.ctl + 0, 0x500u | (unsigned)j, RLX_AGENT); break; }
            }
            float A[4], H[4];
#pragma unroll
            for (int e = 0; e < 4; ++e) { A[e] = need ? __uint_as_float((unsigned)gr[e]) : 1.0f; H[e] = need ? __uint_as_float((unsigned)(gr[e] >> 32)) : 0.0f; }
#pragma unroll
            for (int d = 4; d < 64; d <<= 1) {
                const bool left = (lane & d) == 0;
#pragma unroll
                for (int e = 0; e < 4; ++e) { const float Aq = __shfl_xor(A[e], d), Hq = __shfl_xor(H[e], d);
                    const float Hn = left ? fmaf(Aq, H[e], Hq) : fmaf(A[e], Hq, H[e]);
                    A[e] = A[e] * Aq; H[e] = Hn; }
            }
#pragma unroll
            for (int e = 0; e < 4; ++e) hin[e] = __shfl(H[e], fq);
        }
#pragma unroll
        for (int nb = 0; nb < 8; ++nb) {
            const float s0 = pg8::bf_lo(sgq[nb].x), s1 = pg8::bf_hi(sgq[nb].x), s2 = pg8::bf_lo(sgq[nb].y), s3 = pg8::bf_hi(sgq[nb].y);
            const float h0 = fmaf(Ac[nb][0], hin[0], Hl[nb][0]), h1 = fmaf(Ac[nb][1], hin[1], Hl[nb][1]), h2 = fmaf(Ac[nb][2], hin[2], Hl[nb][2]), h3 = fmaf(Ac[nb][3], hin[3], Hl[nb][3]);
            pg8::u32x2 o; o.x = pk2(h0 * s0, h1 * s1); o.y = pk2(h2 * s2, h3 * s3);
            *(GAS pg8::u32x2*)(Yout + (size_t)(b * SEQ + t0 + 16 * nb + fr) * BW + chl) = o;
        }
        __syncthreads();
    }
#undef P5_LOAD_UNIT
}
#undef P5_SCAN_STEP
struct Args { const float* in[18]; float* out; unsigned char* ws; int ph_lo, ph_hi; };
constexpr int N_PHASES = 8;
__global__ void __launch_bounds__(NWAVES * 64, 2) mk_fwd(Args args) {
    extern __shared__ __attribute__((aligned(16))) unsigned char lds[];
    Frame F;
    F.lds = (LAS unsigned char*)lds;
    F.MISC = (volatile LAS unsigned*)(F.lds + MISC_OFF);
    F.tid = threadIdx.x; F.lane = F.tid & 63; F.wave = __builtin_amdgcn_readfirstlane(F.tid >> 6);
    F.G = gridDim.x; { const int bx = blockIdx.x; F.vcu = (F.G % 8 == 0) ? (bx % 8) * (F.G / 8) + bx / 8 : bx; }
    unsigned char* ws = args.ws;
    F.ctl = (gu32*)(ws + WS_CTL);
    F.x = args.in[0]; F.norm_w = args.in[1]; F.a_w_in = args.in[2]; F.a_ln_w = args.in[3]; F.a_ln_b = args.in[4]; F.a_w_s = args.in[5]; F.a_b_s = args.in[6]; F.a_w_out = args.in[7];
    F.b_w_in = args.in[8]; F.b_conv_w = args.in[9]; F.b_conv_b = args.in[10]; F.b_gate_a_w = args.in[11]; F.b_gate_a_b = args.in[12]; F.b_gate_x_w = args.in[13]; F.b_gate_x_b = args.in[14];
    F.b_lambda = args.in[15]; F.b_w_out = args.in[16]; F.norm_f_w = args.in[17]; F.out = args.out;
    F.W1UG = (bf16*)(ws + WS_W1UG); F.W1V = (bf16*)(ws + WS_W1V); F.W2 = (bf16*)(ws + WS_W2); F.W3 = (bf16*)(ws + WS_W3); F.W4 = (bf16*)(ws + WS_W4); F.WGT = (bf16*)(ws + WS_WG);
    F.AGG = (unsigned long long*)(ws + WS_AGG); F.RS0 = (float*)(ws + WS_RS0); F.SS1 = (float*)(ws + WS_SS1); F.ST = (float*)(ws + WS_ST);
    F.XB16 = (bf16*)(ws + WS_XB16); F.P = (bf16*)(ws + WS_P); F.VT = (bf16*)(ws + WS_VT); F.XBC = (bf16*)(ws + WS_P); F.SG = (bf16*)(ws + WS_VT);
    for (int u = F.tid; u < (LDS_BYTES - LDSCTL_OFF) / 4; u += NWAVES * 64) ((LAS unsigned*)(F.lds + LDSCTL_OFF))[u] = 0u;
    __syncthreads();
    const int lo = args.ph_lo, hi = args.ph_hi;
    const bool use_bar = (hi - lo) > 1;
    XcdBarrier bar; bar.bar = (unsigned*)(F.ctl + CW_BAR); bar.x = 0; bar.st = nullptr;
    if (use_bar) bar = xcd_barrier_post((unsigned*)(F.ctl + CW_BAR), F.MISC + 8);
#define IN(k) (lo <= (k) && (k) < hi)
#define BOTH(k) (IN(k) && IN((k) + 1))
    if (IN(0)) { if (MK_REPEAT == 0) p0_prologue(F); p0_prologue(F); if (BOTH(0)) xcd_barrier(bar); }
#define P1_BODY() do { \
        { pg8::Gemm g{F.XB16, F.W1UG, M, 2 * AW, DM}; pg8::StaticOrder S; S.init(M, 2 * AW, F.G, (int)blockIdx.x); \
          pg8::EpiUG E{F.P, F.RS0}; \
          pg8::gemm_phase<pg8::EpiUG, pg8::StaticOrder, PG8_ALIGN, PG8_SP2>(F.lds + RING_OFF, g, S, E); } \
        { pg8::Gemm g{F.W1V, F.XB16, AW, M, DM}; pg8::StaticOrder S; S.init(AW, M, F.G, (int)blockIdx.x); \
          pg8::EpiVT E{F.VT, F.RS0, F.ST, M}; \
          pg8::gemm_phase<pg8::EpiVT, pg8::StaticOrder, PG8_ALIGN, PG8_SP2>(F.lds + RING_OFF, g, S, E); } } while (0)
    if (IN(1)) {
        if (MK_REPEAT == 1) P1_BODY();
        P1_BODY();
        if (BOTH(1)) xcd_barrier(bar);
    }
    if (IN(2)) {
        if (MK_REPEAT == 2) for (int u = F.vcu; u < (M / CH) * AG; u += F.G) sgu_unit(F, u / AG, u % AG, (bf16*)(ws + WS_SCR));
        for (int u = F.vcu; u < (M / CH) * AG; u += F.G) sgu_unit(F, u / AG, u % AG, F.P);
        if (BOTH(2)) xcd_barrier(bar);
    }
#define P3_BODY() do { pg8::Gemm g{F.P, F.W2, M, DM, AW}; pg8::StaticOrder S; S.init(M, DM, F.G, (int)blockIdx.x); \
        pg8::EpiRes1 E{F.x, F.out, F.XB16, F.SS1}; \
        pg8::gemm_phase<pg8::EpiRes1, pg8::StaticOrder, PG8_ALIGN, PG8_SP2>(F.lds + RING_OFF, g, S, E); } while (0)
    if (IN(3)) {
        if (MK_REPEAT == 3) P3_BODY();
        P3_BODY();
        if (BOTH(3)) xcd_barrier(bar);
    }
#define P4_BODY() do { pg8::Gemm g{F.XB16, F.W3, M, 2 * BW, DM}; pg8::StaticOrder S; S.init(M, 2 * BW, F.G, (int)blockIdx.x); \
        pg8::EpiXG E{F.XBC, F.SG, F.SS1}; \
        pg8::gemm_phase<pg8::EpiXG, pg8::StaticOrder, PG8_ALIGN, PG8_SP2>(F.lds + RING_OFF, g, S, E); } while (0)
    if (IN(4)) {
        if (MK_REPEAT == 4) P4_BODY();
        P4_BODY();
        if (BOTH(4)) xcd_barrier(bar);
    }
    if (IN(5)) {
#if P5_LB == 2
        if (MK_REPEAT == 5) rglru_phase(F, (bf16*)(ws + WS_SCR));
        rglru_phase(F, F.SG);
#elif P5_LB == 1
        if (MK_REPEAT == 5) for (int u = F.vcu; u < P5_UNITS; u += F.G) rglru_unit(F, u, (bf16*)(ws + WS_SCR), P5_PROBE);
        for (int u = F.vcu; u < P5_UNITS; u += F.G) rglru_unit(F, u, F.SG);
#else
        if (MK_REPEAT == 5) for (int u = F.vcu; u < NBATCH * BH; u += F.G) rglru_unit(F, u / BH, u % BH, (bf16*)(ws + WS_SCR));
        for (int u = F.vcu; u < NBATCH * BH; u += F.G) rglru_unit(F, u / BH, u % BH, F.SG);
#endif
        if (BOTH(5)) xcd_barrier(bar);
    }
    if (IN(6)) {
        pg8::Gemm g{F.SG, F.W4, M, DM, BW}; pg8::StaticOrder S; S.init(M, DM, F.G, (int)blockIdx.x);
        if (MK_REPEAT == 6) { pg8::EpiRes2 E0{F.out, (float*)(ws + WS_SCR)}; pg8::gemm_phase<pg8::EpiRes2, pg8::StaticOrder, PG8_ALIGN, PG8_SP2>(F.lds + RING_OFF, g, S, E0); }
        pg8::EpiRes2 E{F.out, F.out};
        pg8::gemm_phase<pg8::EpiRes2, pg8::StaticOrder, PG8_ALIGN, PG8_SP2>(F.lds + RING_OFF, g, S, E);
        if (BOTH(6)) xcd_barrier(bar);
    }
    if (IN(7)) {
        const int gw = F.vcu * NWAVES + F.wave, NGW = F.G * NWAVES;
        for (int rep = (MK_REPEAT == 7 ? 0 : 1); rep < 2; ++rep)
        for (int m = gw; m < M; m += NGW) {
            GAS f32x4* xr = (GAS f32x4*)(F.out + (size_t)m * DM) + F.lane; GAS f32x4* xo = (rep == 0) ? (GAS f32x4*)((float*)(ws + WS_SCR) + (size_t)m * DM) + F.lane : xr;
            f32x4 v[4]; float s = 0.f;
#pragma unroll
            for (int j = 0; j < 4; ++j) { v[j] = xr[64 * j]; s += (v[j].x * v[j].x + v[j].y * v[j].y) + (v[j].z * v[j].z + v[j].w * v[j].w); }
            s = wave_sum(s);
            const float rstd = 1.0f / sqrtf(s * (1.0f / DM) + 1e-6f);
#pragma unroll
            for (int j = 0; j < 4; ++j) { const f32x4 ww = *((const GAS f32x4*)F.norm_f_w + F.lane + 64 * j); xo[64 * j] = v[j] * rstd * ww; }
        }
    }
#undef IN
#undef BOTH
}

#ifndef MK_N_LAUNCHES
#define MK_N_LAUNCHES 1
#endif
extern "C" void kernel_launch(void* const* d_in, const int* in_sizes, int n_in, void* d_out, int out_size, void* d_ws, size_t ws_size, hipStream_t stream) {
    static int grid = 0;
    if (grid == 0) {
        if (n_in != 18 || in_sizes[0] != M * DM || out_size != M * DM || ws_size < WS_END) { fprintf(stderr, "kernel_launch: unexpected shapes (n_in %d, in0 %d, out %d, ws %zu); nothing launched\n", n_in, n_in > 0 ? in_sizes[0] : -1, out_size, ws_size); grid = -1; return; }
        int dev = 0, cus = 0, per_cu = 0;
        if (hipGetDevice(&dev) != hipSuccess || hipDeviceGetAttribute(&cus, hipDeviceAttributeMultiprocessorCount, dev) != hipSuccess) { fprintf(stderr, "kernel_launch: device query failed\n"); grid = -1; return; }
        if (hipFuncSetAttribute((const void*)mk_fwd, hipFuncAttributeMaxDynamicSharedMemorySize, LDS_BYTES) != hipSuccess) { fprintf(stderr, "kernel_launch: hipFuncSetAttribute failed\n"); grid = -1; return; }
        if (hipOccupancyMaxActiveBlocksPerMultiprocessor(&per_cu, (const void*)mk_fwd, NWAVES * 64, LDS_BYTES) != hipSuccess || per_cu < 1)
            fprintf(stderr, "kernel_launch: note: occupancy query reports %d workgroups per CU\n", per_cu);
        (void)hipGetLastError();
        grid = cus;
    }
    if (grid < 0) return;
    if (hipMemsetAsync((char*)d_ws + WS_CTL, 0, CTL_ZERO_BYTES, stream) != hipSuccess) { fprintf(stderr, "kernel_launch: hipMemsetAsync failed\n"); return; }
    Args a{};
    for (int i = 0; i < 18; ++i) a.in[i] = (const float*)d_in[i];
    a.out = (float*)d_out; a.ws = (unsigned char*)d_ws;
#if MK_N_LAUNCHES == 1
    a.ph_lo = 0; a.ph_hi = N_PHASES;
    hipLaunchKernelGGL(mk_fwd, dim3(grid), dim3(NWAVES * 64), LDS_BYTES, stream, a);
#else
    for (int p = 0; p < N_PHASES; ++p) { a.ph_lo = p; a.ph_hi = p + 1; hipLaunchKernelGGL(mk_fwd, dim3(grid), dim3(NWAVES * 64), LDS_BYTES, stream, a); }
#endif
    const hipError_t le = hipPeekAtLastError();
    if (le != hipSuccess) fprintf(stderr, "kernel_launch: launch failed: %s (grid %d)\n", hipGetErrorName(le), grid);
}
```
